# Optimizing an MI355X kernel written in HIP

```python
import math
import jax, jax.numpy as jnp
from jax import lax
import numpy as np

D_MODEL = 1024
BATCH = 4
SEQ = 4096
DEPTH = 1

CHUNK = 64
LEFT_CHUNKS = 8
BAND = LEFT_CHUNKS + 1
N_HEADS = 16
HEAD_DIM = 64
D_ATTN = N_HEADS * HEAD_DIM
MAX_REL = 128
D_RNN = D_MODEL
N_RG_BLOCKS = 16
RG_BLOCK = D_RNN // N_RG_BLOCKS
CONV_W = 4
RG_C = 8.0
D_FF = ((8 * D_MODEL // 3 + 255) // 256) * 256
IN_COLS = 3 * D_ATTN + 2 * D_RNN + 2 * D_MODEL
EPS = 1e-6
NEG_INF = -1e30

kernel_name = "hybrid_chunked_attn_rglru_gated_block"


def rmsnorm(x, g):
    xf = x.astype(jnp.float32)
    var = jnp.mean(xf * xf, axis=-1, keepdims=True)
    return (xf * lax.rsqrt(var + EPS) * g.astype(jnp.float32)).astype(x.dtype)


def rel_bias_band(table):
    i = jnp.arange(CHUNK)[:, None]
    m = jnp.arange(BAND * CHUNK)[None, :]
    dist = i - m + LEFT_CHUNKS * CHUNK
    idx = jnp.clip(dist, -MAX_REL, MAX_REL) + MAX_REL
    return table[:, idx]


def chunked_band_attention(q, k, v, rel_table):
    B, S, _ = q.shape
    nc = S // CHUNK
    q = q.reshape(B, nc, CHUNK, N_HEADS, HEAD_DIM)
    k = k.reshape(B, nc, CHUNK, N_HEADS, HEAD_DIM)
    v = v.reshape(B, nc, CHUNK, N_HEADS, HEAD_DIM)
    pad = jnp.zeros((B, LEFT_CHUNKS, CHUNK, N_HEADS, HEAD_DIM), k.dtype)
    kp = jnp.concatenate([pad, k], axis=1)
    vp = jnp.concatenate([pad, v], axis=1)
    kb = jnp.concatenate([kp[:, j:j + nc] for j in range(BAND)], axis=2)
    vb = jnp.concatenate([vp[:, j:j + nc] for j in range(BAND)], axis=2)
    scale = 1.0 / math.sqrt(HEAD_DIM)
    s = jnp.einsum('bnqhd,bnkhd->bhnqk', q, kb).astype(jnp.float32) * scale
    s = s + rel_bias_band(rel_table).astype(jnp.float32)[None, :, None, :, :]
    key_chunk = jnp.arange(nc)[:, None] - LEFT_CHUNKS + (jnp.arange(BAND * CHUNK)[None, :] // CHUNK)
    valid = key_chunk >= 0
    s = jnp.where(valid[None, None, :, None, :], s, NEG_INF)
    p = jax.nn.softmax(s, axis=-1).astype(v.dtype)
    o = jnp.einsum('bhnqk,bnkhd->bnqhd', p, vb)
    return o.reshape(B, S, D_ATTN)


def causal_depthwise_conv(x, w, b):
    S = x.shape[1]
    xp = jnp.pad(x, ((0, 0), (CONV_W - 1, 0), (0, 0)))
    y = sum(xp[:, j:j + S] * w[j] for j in range(CONV_W))
    return y + b


def rg_lru(x, w_r, b_r, w_i, b_i, lam):
    B, S, D = x.shape
    xb = x.reshape(B, S, N_RG_BLOCKS, RG_BLOCK)
    r = jax.nn.sigmoid(jnp.einsum('bsnd,nde->bsne', xb, w_r).reshape(B, S, D) + b_r)
    i = jax.nn.sigmoid(jnp.einsum('bsnd,nde->bsne', xb, w_i).reshape(B, S, D) + b_i)
    log_a = -RG_C * r.astype(jnp.float32) * jax.nn.softplus(-lam.astype(jnp.float32))
    a = jnp.exp(log_a)
    mult = jnp.sqrt(-jnp.expm1(2.0 * log_a))
    bx = mult * (i * x).astype(jnp.float32)

    def combine(left, right):
        a1, b1 = left
        a2, b2 = right
        return a1 * a2, a2 * b1 + b2

    _, h = lax.associative_scan(combine, (a, bx), axis=1)
    return h.astype(x.dtype)


def setup_inputs(seed: int = 0) -> dict:
    key = jax.random.key(seed)
    ks = jax.random.split(key, 20)
    L = DEPTH

    def nrm(k, shape, fan_in):
        return jax.random.normal(k, shape, jnp.float32) * (fan_in ** -0.5)

    x = jax.random.normal(ks[0], (BATCH, SEQ, D_MODEL), jnp.float32)
    norm_mix_g = 1.0 + 0.05 * jax.random.normal(ks[1], (L, D_MODEL), jnp.float32)
    w_in = nrm(ks[2], (L, D_MODEL, IN_COLS), D_MODEL)
    b_merge = 0.01 * jax.random.normal(ks[3], (L, 2 * D_MODEL), jnp.float32)
    rel_table = 0.5 * jax.random.normal(ks[4], (L, N_HEADS, 2 * MAX_REL + 1), jnp.float32)
    w_attn_out = nrm(ks[5], (L, D_ATTN, D_MODEL), D_ATTN)
    conv_w = nrm(ks[6], (L, CONV_W, D_RNN), CONV_W)
    conv_b = 0.01 * jax.random.normal(ks[7], (L, D_RNN), jnp.float32)
    w_rg_r = nrm(ks[8], (L, N_RG_BLOCKS, RG_BLOCK, RG_BLOCK), RG_BLOCK)
    b_rg_r = 0.01 * jax.random.normal(ks[9], (L, D_RNN), jnp.float32)
    w_rg_i = nrm(ks[10], (L, N_RG_BLOCKS, RG_BLOCK, RG_BLOCK), RG_BLOCK)
    b_rg_i = 0.01 * jax.random.normal(ks[11], (L, D_RNN), jnp.float32)
    u = jax.random.uniform(ks[12], (L, D_RNN), jnp.float32, 0.9, 0.999)
    a0 = u ** (1.0 / RG_C)
    rg_lambda = jnp.log(a0) - jnp.log1p(-a0)
    w_rnn_out = nrm(ks[13], (L, D_RNN, D_MODEL), D_RNN)
    w_o = nrm(ks[14], (L, D_MODEL, D_MODEL), D_MODEL)
    norm_ffn_g = 1.0 + 0.05 * jax.random.normal(ks[15], (L, D_MODEL), jnp.float32)
    w_ffn_in = nrm(ks[16], (L, D_MODEL, 2 * D_FF), D_MODEL)
    w_ffn_out = nrm(ks[17], (L, D_FF, D_MODEL), D_FF)
    final_norm_g = 1.0 + 0.05 * jax.random.normal(ks[18], (D_MODEL,), jnp.float32)
    return {"x": x, "norm_mix_g": norm_mix_g, "w_in": w_in, "b_merge": b_merge,
            "rel_table": rel_table, "w_attn_out": w_attn_out, "conv_w": conv_w,
            "conv_b": conv_b, "w_rg_r": w_rg_r, "b_rg_r": b_rg_r, "w_rg_i": w_rg_i,
            "b_rg_i": b_rg_i, "rg_lambda": rg_lambda, "w_rnn_out": w_rnn_out, "w_o": w_o,
            "norm_ffn_g": norm_ffn_g, "w_ffn_in": w_ffn_in, "w_ffn_out": w_ffn_out,
            "final_norm_g": final_norm_g}


def reference(x, norm_mix_g, w_in, b_merge, rel_table, w_attn_out, conv_w, conv_b,
              w_rg_r, b_rg_r, w_rg_i, b_rg_i, rg_lambda, w_rnn_out, w_o,
              norm_ffn_g, w_ffn_in, w_ffn_out, final_norm_g):
    h = x
    splits = [D_ATTN, 2 * D_ATTN, 3 * D_ATTN, 3 * D_ATTN + D_RNN,
              3 * D_ATTN + 2 * D_RNN, 3 * D_ATTN + 2 * D_RNN + D_MODEL]
    for l in range(DEPTH):
        xn = rmsnorm(h, norm_mix_g[l])
        u = jnp.einsum('bsd,de->bse', xn, w_in[l])
        q, k, v, xr, gr, ga, gb = jnp.split(u, splits, axis=-1)
        ya = chunked_band_attention(q, k, v, rel_table[l]) @ w_attn_out[l]
        xc = causal_depthwise_conv(xr, conv_w[l], conv_b[l])
        hr = rg_lru(xc, w_rg_r[l], b_rg_r[l], w_rg_i[l], b_rg_i[l], rg_lambda[l])
        yb = (hr * jax.nn.gelu(gr)) @ w_rnn_out[l]
        gates = jax.nn.sigmoid(jnp.concatenate([ga, gb], axis=-1) + b_merge[l])
        g_a, g_b = jnp.split(gates, 2, axis=-1)
        h = h + (g_a * ya + g_b * yb) @ w_o[l]
        hn = rmsnorm(h, norm_ffn_g[l])
        gu = hn @ w_ffn_in[l]
        g, up = jnp.split(gu, 2, axis=-1)
        h = h + (jax.nn.silu(g) * up) @ w_ffn_out[l]
    return rmsnorm(h, final_norm_g)
```

```cpp
#include <hip/hip_runtime.h>
#include <hip/hip_cooperative_groups.h>
#include <cstdio>
#include <cstdint>
namespace cg = cooperative_groups;
namespace pg8 {
#define PG8_LAS __attribute__((address_space(3)))
typedef unsigned short bf16_t;
typedef short bf16x8 __attribute__((ext_vector_type(8)));
typedef float f32x4 __attribute__((ext_vector_type(4)));
typedef unsigned u32x4 __attribute__((ext_vector_type(4)));
constexpr int BM = 256, BK = 64, HALF = 128, HTB = HALF * BK * 2  , STAGE_BYTES = 8 * HTB, NXCD = 8, WGM = 8;

__host__ __device__ __forceinline__ int lds_byte(int r, int c) { const int st = (r >> 4) * 2 + (c >> 5), rr = r & 15, cc = c & 31, ob = rr * 64 + cc * 2; return st * 1024 + (ob ^ (((ob >> 9) & 1) << 5)); }
__host__ __device__ __forceinline__ void stage_rc(int b, int& R, int& C) { const int st = b / 1024, sb = b % 1024, swz = sb ^ (((sb >> 9) & 1) << 5); R = (st >> 1) * 16 + swz / 64; C = (st & 1) * 32 + (swz % 64) / 2; }
__host__ __device__ __forceinline__ int perm32(int rho) { const int n = rho >> 4, i = rho & 15; return 8 * (i >> 2) + 4 * n + (i & 3); }

struct Unit { int pm, pn; };
struct Gemm { const bf16_t* A; const bf16_t* Bt; int M, N, K; };

struct StaticOrder {
    int nM, nN, nwg, G, c;
    __host__ __device__ void init(int M, int N, int G_, int c_) { nM = M / BM; nN = N / BM; nwg = nM * nN; G = G_; c = c_; }
    __host__ __device__ bool next(int i, Unit& u) const {
        const long L = (long)i * G + c; if (L >= nwg) return false;
        int wgid = (int)L; { const int q = nwg / NXCD, r = nwg % NXCD, xcd = wgid % NXCD, off = wgid / NXCD; wgid = (xcd < r ? xcd * (q + 1) : r * (q + 1) + (xcd - r) * q) + off; }
        const int nig = WGM * nN, gid = wgid / nig, fm = gid * WGM, gsz = (nM - fm) < WGM ? (nM - fm) : WGM;
        u.pm = fm + ((wgid % nig) % gsz); u.pn = (wgid % nig) / gsz; return true;
    }
    __device__ __forceinline__ void a_ready(const Unit&) const {}
    __device__ __forceinline__ void done(const Unit&) const {}
};

__device__ __forceinline__ unsigned cvt_pk_bf16(float lo, float hi) { unsigned r; asm volatile("v_cvt_pk_bf16_f32 %0, %1, %2" : "=v"(r) : "v"(lo), "v"(hi)); return r; }
typedef float f32x2 __attribute__((ext_vector_type(2)));
__device__ __forceinline__ float sigm(float x) { return __builtin_amdgcn_rcpf(1.0f + __builtin_amdgcn_exp2f(-1.4426950408889634f * x)); }
__device__ __forceinline__ float gelu_t(float x) { return x * sigm(x * (1.5957691216057308f + 0.07135481627159855f * x * x)); }
__device__ __forceinline__ float bf_lo(unsigned w) { return __uint_as_float(w << 16); }
__device__ __forceinline__ float bf_hi(unsigned w) { return __uint_as_float(w & 0xffff0000u); }

struct EpiIn {
    static constexpr bool PERM = true, AFTER_DRAIN = false;
    bf16_t *Q, *K, *V, *XR, *GR, *GA, *GB; const float* bm;
    __device__ __forceinline__ void operator()(const f32x4 (&acc)[2][2][4][2], const Unit& u, int wr, int wc, int fr, int fq) const {
        const int t = u.pn >> 2;
        bf16_t* base = t == 0 ? Q : t == 1 ? K : t == 2 ? V : t == 3 ? XR : t == 4 ? GR : t == 5 ? GA : GB;
        const int col0 = (u.pn & 3) * 256 + wc * 32 + 8 * fq;
        const int row0 = u.pm * BM + wr * 64 + fr;
        f32x4 bv[2][2];
#pragma unroll
        for (int bj = 0; bj < 2; ++bj)
#pragma unroll
            for (int n = 0; n < 2; ++n) bv[bj][n] = (t >= 5) ? *(const f32x4*)(bm + (t - 5) * 1024 + col0 + bj * HALF + 4 * n) : (f32x4){0.f, 0.f, 0.f, 0.f};
#pragma unroll
        for (int ai = 0; ai < 2; ++ai)
#pragma unroll
            for (int m = 0; m < 4; ++m) { bf16_t* rowp = base + (size_t)(row0 + ai * HALF + m * 16) * 1024 + col0;
#pragma unroll
                for (int bj = 0; bj < 2; ++bj) { f32x4 v0 = acc[ai][bj][m][0] + bv[bj][0], v1 = acc[ai][bj][m][1] + bv[bj][1];
                    if (t == 0) { v0 = v0 * 0.125f; v1 = v1 * 0.125f; }
                    else if (t == 4) { v0 = (f32x4){gelu_t(v0[0]), gelu_t(v0[1]), gelu_t(v0[2]), gelu_t(v0[3])}; v1 = (f32x4){gelu_t(v1[0]), gelu_t(v1[1]), gelu_t(v1[2]), gelu_t(v1[3])}; }
                    else if (t >= 5) { v0 = (f32x4){sigm(v0[0]), sigm(v0[1]), sigm(v0[2]), sigm(v0[3])}; v1 = (f32x4){sigm(v1[0]), sigm(v1[1]), sigm(v1[2]), sigm(v1[3])}; }
                    u32x4 w; w.x = cvt_pk_bf16(v0[0], v0[1]); w.y = cvt_pk_bf16(v0[2], v0[3]); w.z = cvt_pk_bf16(v1[0], v1[1]); w.w = cvt_pk_bf16(v1[2], v1[3]);
                    *(u32x4*)(rowp + bj * HALF) = w; } }
    }
};

struct EpiGateA {
    static constexpr bool PERM = true, AFTER_DRAIN = false;
    const bf16_t* G; float* T;
    __device__ __forceinline__ void operator()(const f32x4 (&acc)[2][2][4][2], const Unit& u, int wr, int wc, int fr, int fq) const {
        const int col0 = u.pn * BM + wc * 32 + 8 * fq, row0 = u.pm * BM + wr * 64 + fr;
#pragma unroll
        for (int ai = 0; ai < 2; ++ai)
#pragma unroll
            for (int m = 0; m < 4; ++m) { const size_t off = (size_t)(row0 + ai * HALF + m * 16) * 1024 + col0;
#pragma unroll
                for (int bj = 0; bj < 2; ++bj) { const u32x4 g = *(const u32x4*)(G + off + bj * HALF);
                    const f32x4 a0 = acc[ai][bj][m][0], a1 = acc[ai][bj][m][1];
                    *(f32x4*)(T + off + bj * HALF) = (f32x4){a0[0] * bf_lo(g.x), a0[1] * bf_hi(g.x), a0[2] * bf_lo(g.y), a0[3] * bf_hi(g.y)};
                    *(f32x4*)(T + off + bj * HALF + 4) = (f32x4){a1[0] * bf_lo(g.z), a1[1] * bf_hi(g.z), a1[2] * bf_lo(g.w), a1[3] * bf_hi(g.w)}; } }
    }
};
struct EpiGateB {
    static constexpr bool PERM = true, AFTER_DRAIN = false;
    const bf16_t* G; const float* T; bf16_t* O;
    __device__ __forceinline__ void operator()(const f32x4 (&acc)[2][2][4][2], const Unit& u, int wr, int wc, int fr, int fq) const {
        const int col0 = u.pn * BM + wc * 32 + 8 * fq, row0 = u.pm * BM + wr * 64 + fr;
#pragma unroll
        for (int ai = 0; ai < 2; ++ai)
#pragma unroll
            for (int m = 0; m < 4; ++m) { const size_t off = (size_t)(row0 + ai * HALF + m * 16) * 1024 + col0;
#pragma unroll
                for (int bj = 0; bj < 2; ++bj) { const u32x4 g = *(const u32x4*)(G + off + bj * HALF);
                    const f32x4 t0 = *(const f32x4*)(T + off + bj * HALF), t1 = *(const f32x4*)(T + off + bj * HALF + 4);
                    const f32x4 a0 = acc[ai][bj][m][0], a1 = acc[ai][bj][m][1];
                    u32x4 w; w.x = cvt_pk_bf16(t0[0] + a0[0] * bf_lo(g.x), t0[1] + a0[1] * bf_hi(g.x)); w.y = cvt_pk_bf16(t0[2] + a0[2] * bf_lo(g.y), t0[3] + a0[3] * bf_hi(g.y));
                    w.z = cvt_pk_bf16(t1[0] + a1[0] * bf_lo(g.z), t1[1] + a1[1] * bf_hi(g.z)); w.w = cvt_pk_bf16(t1[2] + a1[2] * bf_lo(g.w), t1[3] + a1[3] * bf_hi(g.w));
                    *(u32x4*)(O + off + bj * HALF) = w; } }
    }
};
struct EpiResStats {
    static constexpr bool PERM = true, AFTER_DRAIN = true;
    const float* base; float* out; bf16_t* outb; float* ss;
    __device__ __forceinline__ void fused(f32x4 (&acc)[2][2][4][2], const Unit& u, int wr, int wc, int fr, int fq, PG8_LAS unsigned char* lds, int wid, int lane) const {
        PG8_LAS float* P = (PG8_LAS float*)lds;
        const int col0 = u.pn * BM + wc * 32 + 8 * fq, row0 = u.pm * BM + wr * 64 + fr;
#pragma unroll
        for (int ai = 0; ai < 2; ++ai)
#pragma unroll
            for (int m = 0; m < 4; ++m) { const size_t off = (size_t)(row0 + ai * HALF + m * 16) * 1024 + col0; float s = 0.f;
#pragma unroll
                for (int bj = 0; bj < 2; ++bj) {
                    const f32x4 h0 = *(const f32x4*)(base + off + bj * HALF) + acc[ai][bj][m][0], h1 = *(const f32x4*)(base + off + bj * HALF + 4) + acc[ai][bj][m][1];
                    *(f32x4*)(out + off + bj * HALF) = h0; *(f32x4*)(out + off + bj * HALF + 4) = h1;
                    if (outb) { u32x4 w; w.x = cvt_pk_bf16(h0[0], h0[1]); w.y = cvt_pk_bf16(h0[2], h0[3]); w.z = cvt_pk_bf16(h1[0], h1[1]); w.w = cvt_pk_bf16(h1[2], h1[3]); *(u32x4*)(outb + off + bj * HALF) = w; }
                    s += (h0[0] * h0[0] + h0[1] * h0[1]) + (h0[2] * h0[2] + h0[3] * h0[3]) + (h1[0] * h1[0] + h1[1] * h1[1]) + (h1[2] * h1[2] + h1[3] * h1[3]); }
                s += __shfl_xor(s, 16); s += __shfl_xor(s, 32);
                if (fq == 0) P[(ai * HALF + wr * 64 + m * 16 + fr) * 4 + wc] = s; }
        __syncthreads();
        const int tid = wid * 64 + lane;
        if (tid < 256) { const f32x4 p = *(const PG8_LAS f32x4*)(P + tid * 4); ss[(size_t)(u.pm * BM + tid) * 4 + u.pn] = (p[0] + p[1]) + (p[2] + p[3]); }
        __syncthreads();
    }
};
struct EpiSwiGLU {
    static constexpr bool PERM = true, AFTER_DRAIN = false;
    const float* ss; bf16_t* O; int ldo;
    __device__ __forceinline__ void operator()(const f32x4 (&acc)[2][2][4][2], const Unit& u, int wr, int wc, int fr, int fq) const {
        const int col0 = u.pn * HALF + wc * 32 + 8 * fq, row0 = u.pm * BM + wr * 64 + fr;
#pragma unroll
        for (int ai = 0; ai < 2; ++ai)
#pragma unroll
            for (int m = 0; m < 4; ++m) { const int row = row0 + ai * HALF + m * 16; const f32x4 p = *(const f32x4*)(ss + (size_t)row * 4);
                const float rstd = __builtin_amdgcn_rsqf(((p[0] + p[1]) + (p[2] + p[3])) * (1.0f / 1024.0f) + 1e-6f);
                float r[8];
#pragma unroll
                for (int n = 0; n < 2; ++n)
#pragma unroll
                    for (int e = 0; e < 4; ++e) { const float g = acc[ai][0][m][n][e] * rstd, up = acc[ai][1][m][n][e] * rstd; r[n * 4 + e] = g * sigm(g) * up; }
                u32x4 w; w.x = cvt_pk_bf16(r[0], r[1]); w.y = cvt_pk_bf16(r[2], r[3]); w.z = cvt_pk_bf16(r[4], r[5]); w.w = cvt_pk_bf16(r[6], r[7]);
                *(u32x4*)(O + (size_t)row * ldo + col0) = w; }
    }
};

template <class Epi, class Sched, bool ALIGN_EPI = false, bool SP2 = false>
__device__ __forceinline__ void gemm_phase(PG8_LAS unsigned char* lds, const Gemm g, const Sched& S, const Epi& E) {
    const int tid = threadIdx.x, wid = __builtin_amdgcn_readfirstlane(tid >> 6), lane = tid & 63, wr = wid >> 2, wc = wid & 3, fr = lane & 15, fq = lane >> 4;
    const int K = g.K, nt = K / BK;
    unsigned voffA[2], voffB[2];
#pragma unroll
    for (int i = 0; i < 2; ++i) { int R, C; stage_rc(tid * 16 + i * 8192, R, C); const int Rb = Epi::PERM ? ((R & ~31) + perm32(R & 31)) : R;
        voffA[i] = (unsigned)(R * K + C) * 2u; voffB[i] = (unsigned)(Rb * K + C) * 2u; }
    const size_t kstep = (size_t)(BK * 2);
    const size_t hstep = (size_t)HALF * K * 2;
    const size_t tstep = 2 * hstep;
    const unsigned ldsw = (unsigned)wid * 1024u;
    const int aoff = lds_byte(wr * 64 + fr, fq * 8), boff = lds_byte(wc * 32 + fr, fq * 8);
#define PG8_SA(b, h) (((b) * 2 + (h)) * HTB)
#define PG8_SB(b, h) ((4 + (b) * 2 + (h)) * HTB)
#define PG8_STAGE(bufoff, gbase, voff) do { _Pragma("unroll") for (int _i = 0; _i < 2; ++_i) \
        __builtin_amdgcn_global_load_lds((const unsigned*)((const char*)(gbase) + (voff)[_i]), (PG8_LAS unsigned*)(lds + (bufoff) + ldsw + _i * 8192), 16, 0, 0); } while (0)
#define PG8_LDA(dst, b, h) do { _Pragma("unroll") for (int m = 0; m < 4; ++m) _Pragma("unroll") for (int k = 0; k < 2; ++k) dst[m][k] = *(const PG8_LAS bf16x8*)(lds + PG8_SA(b, h) + aoff + m * 2048 + k * 1024); } while (0)
#define PG8_LDB(dst, b, h) do { _Pragma("unroll") for (int n = 0; n < 2; ++n) _Pragma("unroll") for (int k = 0; k < 2; ++k) dst[n][k] = *(const PG8_LAS bf16x8*)(lds + PG8_SB(b, h) + boff + n * 2048 + k * 1024); } while (0)
#define PG8_MMA(ai, bj, At, Bt) do { __builtin_amdgcn_s_setprio(1); _Pragma("unroll") for (int m = 0; m < 4; ++m) _Pragma("unroll") for (int n = 0; n < 2; ++n) _Pragma("unroll") for (int k = 0; k < 2; ++k) \
        acc[ai][bj][m][n] = __builtin_amdgcn_mfma_f32_16x16x32_bf16(Bt[n][k], At[m][k], acc[ai][bj][m][n], 0, 0, 0); __builtin_amdgcn_s_setprio(0); } while (0)
#define PG8_WAIT_V(n) asm volatile("s_waitcnt vmcnt(" #n ")" ::: "memory")
#define PG8_WAIT_L(n) asm volatile("s_waitcnt lgkmcnt(" #n ")" ::: "memory")
#define PG8_BAR __builtin_amdgcn_s_barrier()
#define PG8_SCHED __builtin_amdgcn_sched_barrier(0)
    Unit cur, nxt; int ui = 0;
    if (!S.next(0, cur)) return;
    f32x4 acc[2][2][4][2];
#pragma unroll
    for (int a = 0; a < 2; ++a)
#pragma unroll
        for (int b = 0; b < 2; ++b)
#pragma unroll
            for (int m = 0; m < 4; ++m)
#pragma unroll
                for (int n = 0; n < 2; ++n) acc[a][b][m][n] = (f32x4){0.f, 0.f, 0.f, 0.f};
    bf16x8 At[4][2], B0[2][2], B1[2][2];
    const char* cA = (const char*)g.A + (size_t)cur.pm * tstep; const char* cB = (const char*)g.Bt + (size_t)cur.pn * tstep;
    S.a_ready(cur);
    if constexpr (SP2) {
        PG8_STAGE(PG8_SB(0, 0), cB, voffB); PG8_STAGE(PG8_SB(0, 1), cB + hstep, voffB); PG8_STAGE(PG8_SA(0, 0), cA, voffA); PG8_STAGE(PG8_SA(0, 1), cA + hstep, voffA);
        if (wr == 1) PG8_BAR;
        PG8_WAIT_V(2); PG8_BAR;
        PG8_STAGE(PG8_SB(1, 0), cB + kstep, voffB); PG8_STAGE(PG8_SA(1, 0), cA + kstep, voffA); PG8_STAGE(PG8_SB(1, 1), cB + hstep + kstep, voffB);
        PG8_WAIT_V(6); PG8_BAR;
    } else {
        PG8_STAGE(PG8_SB(0, 0), cB, voffB); PG8_STAGE(PG8_SA(0, 0), cA, voffA); PG8_STAGE(PG8_SB(0, 1), cB + hstep, voffB); PG8_STAGE(PG8_SA(0, 1), cA + hstep, voffA);
        if (wr == 1) PG8_BAR;
        PG8_WAIT_V(4); PG8_BAR;
        PG8_STAGE(PG8_SB(1, 0), cB + kstep, voffB); PG8_STAGE(PG8_SA(1, 0), cA + kstep, voffA); PG8_STAGE(PG8_SB(1, 1), cB + hstep + kstep, voffB);
        PG8_WAIT_V(6); PG8_BAR;
    }
    for (;;) {
        const bool has_next = S.next(ui + 1, nxt);
        const char* nA = has_next ? (const char*)g.A + (size_t)nxt.pm * tstep : cA; const char* nB = has_next ? (const char*)g.Bt + (size_t)nxt.pn * tstep : cB;
        for (int t = 0; t < nt; t += 2) {
            const bool last = (t == nt - 2);
            const char* a1 = cA + (size_t)(t + 1) * kstep;
            const char* a2 = last ? nA : cA + (size_t)(t + 2) * kstep; const char* b2 = last ? nB : cB + (size_t)(t + 2) * kstep;
            const char* a3 = a2 + kstep; const char* b3 = b2 + kstep;
            if (last && has_next) S.a_ready(nxt);
            if constexpr (SP2) {
            PG8_LDB(B0, 0, 0); PG8_LDB(B1, 0, 1); PG8_SCHED; PG8_LDA(At, 0, 0); PG8_STAGE(PG8_SA(1, 1), a1 + hstep, voffA);
            PG8_WAIT_V(8); PG8_WAIT_L(0); PG8_BAR; PG8_MMA(0, 0, At, B0); PG8_MMA(0, 1, At, B1); PG8_BAR; PG8_SCHED;
            PG8_LDA(At, 0, 1); PG8_STAGE(PG8_SB(0, 0), b2, voffB); PG8_STAGE(PG8_SB(0, 1), b2 + hstep, voffB); PG8_STAGE(PG8_SA(0, 0), a2, voffA);
            PG8_WAIT_V(8); PG8_WAIT_L(0); PG8_BAR; PG8_MMA(1, 0, At, B0); PG8_MMA(1, 1, At, B1); PG8_BAR; PG8_SCHED;
            PG8_LDB(B0, 1, 0); PG8_LDB(B1, 1, 1); PG8_SCHED; PG8_LDA(At, 1, 0); PG8_STAGE(PG8_SA(0, 1), a2 + hstep, voffA);
            PG8_WAIT_V(8); PG8_WAIT_L(0); PG8_BAR; PG8_MMA(0, 0, At, B0); PG8_MMA(0, 1, At, B1); PG8_BAR; PG8_SCHED;
            PG8_LDA(At, 1, 1); PG8_STAGE(PG8_SB(1, 0), b3, voffB); PG8_STAGE(PG8_SB(1, 1), b3 + hstep, voffB); PG8_STAGE(PG8_SA(1, 0), a3, voffA);
            PG8_WAIT_V(8); PG8_WAIT_L(0); PG8_BAR; PG8_MMA(1, 0, At, B0); PG8_MMA(1, 1, At, B1); PG8_BAR; PG8_SCHED;
            } else {
            PG8_LDB(B0, 0, 0); PG8_SCHED; PG8_LDA(At, 0, 0); PG8_STAGE(PG8_SA(1, 1), a1 + hstep, voffA);
            PG8_WAIT_L(8); PG8_BAR; PG8_WAIT_L(0); PG8_MMA(0, 0, At, B0); PG8_BAR; PG8_SCHED;
            PG8_LDB(B1, 0, 1); PG8_STAGE(PG8_SB(0, 0), b2, voffB);
            PG8_BAR; PG8_WAIT_L(0); PG8_MMA(0, 1, At, B1); PG8_BAR;
            PG8_LDA(At, 0, 1); PG8_STAGE(PG8_SA(0, 0), a2, voffA);
            PG8_BAR; PG8_WAIT_L(0); PG8_MMA(1, 0, At, B0); PG8_BAR; PG8_SCHED;
            PG8_STAGE(PG8_SB(0, 1), b2 + hstep, voffB);
            PG8_WAIT_V(6); PG8_BAR; PG8_MMA(1, 1, At, B1); PG8_BAR;
            PG8_LDB(B0, 1, 0); PG8_SCHED; PG8_LDA(At, 1, 0); PG8_STAGE(PG8_SA(0, 1), a2 + hstep, voffA);
            PG8_WAIT_L(8); PG8_BAR; PG8_WAIT_L(0); PG8_MMA(0, 0, At, B0); PG8_BAR; PG8_SCHED;
            PG8_LDB(B1, 1, 1); PG8_STAGE(PG8_SB(1, 0), b3, voffB);
            PG8_BAR; PG8_WAIT_L(0); PG8_MMA(0, 1, At, B1); PG8_BAR;
            PG8_LDA(At, 1, 1); PG8_STAGE(PG8_SA(1, 0), a3, voffA);
            PG8_BAR; PG8_WAIT_L(0); PG8_MMA(1, 0, At, B0); PG8_BAR; PG8_SCHED;
            PG8_STAGE(PG8_SB(1, 1), b3 + hstep, voffB);
            PG8_WAIT_V(6); PG8_BAR; PG8_MMA(1, 1, At, B1); PG8_BAR;
            }
        }
        if constexpr (ALIGN_EPI) { if (wr == 0) PG8_BAR; }
        if constexpr (!Epi::AFTER_DRAIN) { E(acc, cur, wr, wc, fr, fq); S.done(cur); }
        if (!has_next) break;
#pragma unroll
        for (int a = 0; a < 2; ++a)
#pragma unroll
            for (int b = 0; b < 2; ++b)
#pragma unroll
                for (int m = 0; m < 4; ++m)
#pragma unroll
                    for (int n = 0; n < 2; ++n) acc[a][b][m][n] = (f32x4){0.f, 0.f, 0.f, 0.f};
        cur = nxt; cA = nA; cB = nB; ++ui;
        if constexpr (ALIGN_EPI) { if (wr == 1) PG8_BAR; }
    }
    PG8_WAIT_V(0);
    if constexpr (!ALIGN_EPI) { if (wr == 0) PG8_BAR; }
    PG8_BAR;
    if constexpr (Epi::AFTER_DRAIN) { E.fused(acc, cur, wr, wc, fr, fq, lds, wid, lane); S.done(cur); }
#undef PG8_SA
#undef PG8_SB
#undef PG8_STAGE
#undef PG8_LDA
#undef PG8_LDB
#undef PG8_MMA
#undef PG8_WAIT_V
#undef PG8_WAIT_L
#undef PG8_BAR
#undef PG8_SCHED
}
}

constexpr int NB = 4, SEQ = 4096, DM = 1024, NH = 16, M = NB * SEQ, NIN = 7 * 1024, DFF = 2816;
constexpr size_t MiB = 1u << 20;
constexpr size_t WS_WIN = 2 * MiB, WS_WAO = 16 * MiB, WS_WRO = 18 * MiB, WS_WO = 20 * MiB, WS_WF1 = 22 * MiB, WS_WF2 = 33 * MiB;
constexpr size_t WS_SS1 = 40 * MiB, WS_SS2 = 41 * MiB;
constexpr size_t WS_Q = 44 * MiB, WS_K = 76 * MiB, WS_V = 108 * MiB, WS_XR = 140 * MiB, WS_GR = 172 * MiB, WS_XN = 204 * MiB;
constexpr size_t WS_ATT = WS_XN;
constexpr size_t WS_RNN = WS_GR;
constexpr size_t WS_T1 = WS_K;
constexpr size_t WS_MIX = WS_Q;
constexpr size_t WS_H = WS_K;
constexpr size_t WS_ACT = WS_XR;
constexpr size_t WS_END = 236 * MiB;

constexpr int LDS_BYTES = 131072 + 4096;
#define LAS __attribute__((address_space(3)))
typedef unsigned short bf16;
typedef unsigned u32x4 __attribute__((ext_vector_type(4)));
typedef unsigned u32x2 __attribute__((ext_vector_type(2)));
typedef float f32x4 __attribute__((ext_vector_type(4)));
typedef float f32x16 __attribute__((ext_vector_type(16)));
typedef short bf16x8 __attribute__((ext_vector_type(8)));
typedef short v4i16_t __attribute__((ext_vector_type(4)));
using pg8::cvt_pk_bf16; using pg8::sigm; using pg8::gelu_t; using pg8::bf_lo; using pg8::bf_hi;

__device__ __forceinline__ float wave_sum(float v) {
#pragma unroll
    for (int o = 1; o < 64; o <<= 1) v += __shfl_xor(v, o);
    return v;
}
__device__ __forceinline__ void transpose_item(const float* W, int K, int N, bf16* WT, int k0, int n0, int drow0, const float* kscale, LAS float* scr, int lane) {
#pragma unroll 8
    for (int i = 0; i < 32; ++i) { const int kk = 2 * i + (lane >> 5); float v = W[(size_t)(k0 + kk) * N + n0 + (lane & 31)]; if (kscale) v *= kscale[k0 + kk]; scr[kk * 33 + (lane & 31)] = v; }
    asm volatile("s_waitcnt lgkmcnt(0)" ::: "memory");
    const int c = lane & 7;
#pragma unroll
    for (int j = 0; j < 4; ++j) { const int n = (lane >> 3) + 8 * j; const LAS float* s = scr + (8 * c) * 33 + n;
        u32x4 o; o.x = cvt_pk_bf16(s[0 * 33], s[1 * 33]); o.y = cvt_pk_bf16(s[2 * 33], s[3 * 33]); o.z = cvt_pk_bf16(s[4 * 33], s[5 * 33]); o.w = cvt_pk_bf16(s[6 * 33], s[7 * 33]);
        *(u32x4*)(WT + (size_t)(drow0 + n) * K + k0 + 8 * c) = o; }
    asm volatile("s_waitcnt lgkmcnt(0)" ::: "memory");
}

struct Args { const float* in[19]; float* out; unsigned char* ws; };
enum { I_X = 0, I_NMG, I_WIN, I_BM, I_REL, I_WAO, I_CW, I_CB, I_WRR, I_BRR, I_WRI, I_BRI, I_LAM, I_WRO, I_WO, I_NFG, I_WF1, I_WF2, I_FNG };

__device__ __forceinline__ void p0_prologue(const Args& a, LAS unsigned char* lds, int gw, int NGW, int wave, int lane) {
    LAS float* scr = (LAS float*)(lds + wave * 16384);
    unsigned char* ws = a.ws;
    constexpr int I_IN = 16 * (NIN / 32), I_SQ = 16 * 32, I_F1 = 16 * (2 * DFF / 32), I_F2 = (DFF / 64) * 32;
    constexpr int NITEMS = I_IN + 3 * I_SQ + I_F1 + I_F2;
    for (int it = gw; it < NITEMS; it += NGW) {
        int r = it;
        if (r < I_IN) { const int nb = NIN / 32, kb = r / nb, n0 = (r % nb) * 32; transpose_item(a.in[I_WIN], DM, NIN, (bf16*)(ws + WS_WIN), kb * 64, n0, n0, nullptr, scr, lane); continue; } r -= I_IN;
        if (r < 3 * I_SQ) { const int w = r / I_SQ; r -= w * I_SQ; const int kb = r / 32, n0 = (r % 32) * 32;
            const float* W = w == 0 ? a.in[I_WAO] : w == 1 ? a.in[I_WRO] : a.in[I_WO]; bf16* D = (bf16*)(ws + (w == 0 ? WS_WAO : w == 1 ? WS_WRO : WS_WO));
            transpose_item(W, DM, DM, D, kb * 64, n0, n0, nullptr, scr, lane); continue; } r -= 3 * I_SQ;
        if (r < I_F1) { const int nb = 2 * DFF / 32, kb = r / nb, n0 = (r % nb) * 32; const int half = n0 / DFF, jj = n0 % DFF, drow = (jj / 128) * 256 + half * 128 + (jj % 128);
            transpose_item(a.in[I_WF1], DM, 2 * DFF, (bf16*)(ws + WS_WF1), kb * 64, n0, drow, a.in[I_NFG], scr, lane); continue; } r -= I_F1;
        { const int kb = r / 32, n0 = (r % 32) * 32; transpose_item(a.in[I_WF2], DFF, DM, (bf16*)(ws + WS_WF2), kb * 64, n0, n0, nullptr, scr, lane); }
    }
    const float* x = a.in[I_X]; const float* g = a.in[I_NMG]; bf16* XN = (bf16*)(ws + WS_XN);
    f32x4 gv[4];
#pragma unroll
    for (int j = 0; j < 4; ++j) gv[j] = *((const f32x4*)g + lane + 64 * j);
    for (int m = gw; m < M; m += NGW) {
        const f32x4* xr = (const f32x4*)(x + (size_t)m * DM) + lane; f32x4 v[4]; float s = 0.f;
#pragma unroll
        for (int j = 0; j < 4; ++j) { v[j] = xr[64 * j]; s += (v[j].x * v[j].x + v[j].y * v[j].y) + (v[j].z * v[j].z + v[j].w * v[j].w); }
        const float rstd = __builtin_amdgcn_rsqf(wave_sum(s) * (1.f / DM) + 1e-6f);
        u32x2* o8 = (u32x2*)(XN + (size_t)m * DM) + lane;
#pragma unroll
        for (int j = 0; j < 4; ++j) { u32x2 w; w.x = cvt_pk_bf16(v[j].x * rstd * gv[j].x, v[j].y * rstd * gv[j].y); w.y = cvt_pk_bf16(v[j].z * rstd * gv[j].z, v[j].w * rstd * gv[j].w); o8[64 * j] = w; }
    }
}

constexpr int KST = 144, VST = 192, KBUF = 64 * KST, VBUF = 64 * VST;
constexpr int AL_K = 0, AL_V = 2 * KBUF, AL_TAB = AL_V + 2 * VBUF;
__device__ __forceinline__ void attn_unit(LAS unsigned char* lds, const bf16* Q, const bf16* K, const bf16* V, bf16* O, const float* rel, int b, int h, int qg, int tid, int wid, int lane) {
    const int r32 = lane & 31, hi = lane >> 5;
    LAS float* TAB = (LAS float*)(lds + AL_TAB);
    const int cq = qg * 4 + (wid >> 1), qoff = (wid & 1) * 32;
    const int kt0 = qg * 4 - 8 < 0 ? 0 : qg * 4 - 8, kt1 = qg * 4 + 3;
    if (tid < 257) TAB[tid] = rel[h * 257 + tid] * 1.4426950408889634f;
    const size_t tok0 = (size_t)b * SEQ;
    bf16x8 qf[4];
    { const bf16* qp = Q + (tok0 + cq * 64 + qoff + r32) * DM + h * 64 + hi * 8;
#pragma unroll
      for (int d0 = 0; d0 < 4; ++d0) qf[d0] = *(const bf16x8*)(qp + d0 * 16); }
    const int srow = tid >> 3, sch = tid & 7;
    const bf16* kg = K + (tok0 + srow) * DM + h * 64 + sch * 8; const bf16* vg = V + (tok0 + srow) * DM + h * 64 + sch * 8;
    u32x4 kreg = *(const u32x4*)(kg + (size_t)kt0 * 64 * DM), vreg = *(const u32x4*)(vg + (size_t)kt0 * 64 * DM);
    float m_run = -1e30f, l_run = 0.f; f32x16 o0, o1;
#pragma unroll
    for (int r = 0; r < 16; ++r) { o0[r] = 0.f; o1[r] = 0.f; }
    const int vlane = (4 * hi + ((lane & 15) >> 2)) * VST + (16 * ((lane >> 4) & 1) + 4 * (lane & 3)) * 2;
    for (int kt = kt0; kt <= kt1; ++kt) {
        const int buf = (kt - kt0) & 1;
        *(LAS u32x4*)(lds + AL_K + buf * KBUF + srow * KST + sch * 16) = kreg;
        *(LAS u32x4*)(lds + AL_V + buf * VBUF + srow * VST + sch * 16) = vreg;
        __syncthreads();
        if (kt < kt1) { kreg = *(const u32x4*)(kg + (size_t)(kt + 1) * 64 * DM); vreg = *(const u32x4*)(vg + (size_t)(kt + 1) * 64 * DM); }
        if (kt >= cq - 8 && kt <= cq) {
            f32x16 p0, p1;
#pragma unroll
            for (int r = 0; r < 16; ++r) { p0[r] = 0.f; p1[r] = 0.f; }
            const LAS unsigned char* kb = lds + AL_K + buf * KBUF + r32 * KST + hi * 16;
#pragma unroll
            for (int d0 = 0; d0 < 4; ++d0) {
                const bf16x8 a0 = *(const LAS bf16x8*)(kb + d0 * 32), a1 = *(const LAS bf16x8*)(kb + 32 * KST + d0 * 32);
                p0 = __builtin_amdgcn_mfma_f32_32x32x16_bf16(a0, qf[d0], p0, 0, 0, 0);
                p1 = __builtin_amdgcn_mfma_f32_32x32x16_bf16(a1, qf[d0], p1, 0, 0, 0);
            }
            const int dc = cq - kt;
            if (dc >= 3) { const float bc = TAB[256];
#pragma unroll
                for (int r = 0; r < 16; ++r) { p0[r] = p0[r] * 1.4426950408889634f + bc; p1[r] = p1[r] * 1.4426950408889634f + bc; }
            } else { const int D0 = dc * 64 + qoff + r32 - 4 * hi + 128;
#pragma unroll
                for (int r = 0; r < 16; ++r) { const int kv = (r & 3) + 8 * (r >> 2); int i0 = D0 - kv, i1 = D0 - kv - 32;
                    i0 = i0 > 256 ? 256 : i0; i1 = i1 > 256 ? 256 : i1; i0 = i0 < 0 ? 0 : i0; i1 = i1 < 0 ? 0 : i1;
                    p0[r] = p0[r] * 1.4426950408889634f + TAB[i0]; p1[r] = p1[r] * 1.4426950408889634f + TAB[i1]; }
            }
            float mt = fmaxf(p0[0], p1[0]);
#pragma unroll
            for (int r = 1; r < 16; ++r) mt = fmaxf(mt, fmaxf(p0[r], p1[r]));
            mt = fmaxf(mt, __shfl_xor(mt, 32));
            const float m_new = fmaxf(m_run, mt), alpha = __builtin_amdgcn_exp2f(m_run - m_new);
            float ps = 0.f;
#pragma unroll
            for (int r = 0; r < 16; ++r) { p0[r] = __builtin_amdgcn_exp2f(p0[r] - m_new); p1[r] = __builtin_amdgcn_exp2f(p1[r] - m_new); ps += p0[r] + p1[r]; }
            l_run = l_run * alpha + ps; m_run = m_new;
#pragma unroll
            for (int r = 0; r < 16; ++r) { o0[r] *= alpha; o1[r] *= alpha; }
            u32x4 pw[4];
            pw[0] = (u32x4){cvt_pk_bf16(p0[0], p0[1]), cvt_pk_bf16(p0[2], p0[3]), cvt_pk_bf16(p0[4], p0[5]), cvt_pk_bf16(p0[6], p0[7])};
            pw[1] = (u32x4){cvt_pk_bf16(p0[8], p0[9]), cvt_pk_bf16(p0[10], p0[11]), cvt_pk_bf16(p0[12], p0[13]), cvt_pk_bf16(p0[14], p0[15])};
            pw[2] = (u32x4){cvt_pk_bf16(p1[0], p1[1]), cvt_pk_bf16(p1[2], p1[3]), cvt_pk_bf16(p1[4], p1[5]), cvt_pk_bf16(p1[6], p1[7])};
            pw[3] = (u32x4){cvt_pk_bf16(p1[8], p1[9]), cvt_pk_bf16(p1[10], p1[11]), cvt_pk_bf16(p1[12], p1[13]), cvt_pk_bf16(p1[14], p1[15])};
            const LAS unsigned char* vb = lds + AL_V + buf * VBUF + vlane;
#pragma unroll
            for (int ks = 0; ks < 4; ++ks) {
#pragma unroll
                for (int d0 = 0; d0 < 2; ++d0) {
                    const v4i16_t lo = __builtin_amdgcn_ds_read_tr16_b64_v4i16((LAS v4i16_t*)(vb + (16 * ks) * VST + d0 * 64));
                    const v4i16_t hh = __builtin_amdgcn_ds_read_tr16_b64_v4i16((LAS v4i16_t*)(vb + (16 * ks + 8) * VST + d0 * 64));
                    const bf16x8 vf = (bf16x8){lo[0], lo[1], lo[2], lo[3], hh[0], hh[1], hh[2], hh[3]};
                    if (d0 == 0) o0 = __builtin_amdgcn_mfma_f32_32x32x16_bf16(vf, __builtin_bit_cast(bf16x8, pw[ks]), o0, 0, 0, 0);
                    else         o1 = __builtin_amdgcn_mfma_f32_32x32x16_bf16(vf, __builtin_bit_cast(bf16x8, pw[ks]), o1, 0, 0, 0);
                }
            }
        }
    }
    l_run += __shfl_xor(l_run, 32);
    const float inv = 1.0f / l_run;
    bf16* op = O + (tok0 + cq * 64 + qoff + r32) * DM + h * 64 + 4 * hi;
#pragma unroll
    for (int g = 0; g < 4; ++g) {
        u32x2 w0, w1; w0.x = cvt_pk_bf16(o0[4 * g] * inv, o0[4 * g + 1] * inv); w0.y = cvt_pk_bf16(o0[4 * g + 2] * inv, o0[4 * g + 3] * inv);
        w1.x = cvt_pk_bf16(o1[4 * g] * inv, o1[4 * g + 1] * inv); w1.y = cvt_pk_bf16(o1[4 * g + 2] * inv, o1[4 * g + 3] * inv);
        *(u32x2*)(op + 8 * g) = w0; *(u32x2*)(op + 32 + 8 * g) = w1;
    }
    __syncthreads();
}

constexpr int RL_CW = 0, RL_AGG = 2048;
template <bool WRITE>
__device__ __forceinline__ void rnn_pass(const bf16* XR, const bf16* GR, bf16* OUT, LAS unsigned char* lds, const bf16x8 (&af)[4], const float (&br)[8], const float (&bi)[8], const float (&sp8)[8],
                                         float (&Hc)[8], float (&Ar)[8], int b, int n, int q, int wid, int lane) {
    const int r32 = lane & 31, hi = lane >> 5;
    const LAS float* CW = (const LAS float*)(lds + RL_CW);
    for (int tile = 0; tile < 16; ++tile) {
        const int t = wid * 512 + tile * 32 + r32;
        const bf16* xp = XR + ((size_t)b * SEQ + t) * DM + n * 64 + hi * 8;
        float own[8]; bf16x8 bfrag[4];
#pragma unroll
        for (int ks = 0; ks < 4; ++ks) {
            const LAS f32x4* cw = (const LAS f32x4*)(CW + (ks * 2 + hi) * 40);
            f32x4 c0 = cw[8], c1 = cw[9];
#pragma unroll
            for (int tap = 0; tap < 4; ++tap) {
                u32x4 xv = (u32x4){0u, 0u, 0u, 0u};
                if (t - 3 + tap >= 0) xv = *(const u32x4*)(xp + (ptrdiff_t)(tap - 3) * DM + ks * 16);
                const f32x4 w0 = cw[tap * 2], w1 = cw[tap * 2 + 1];
                c0 += (f32x4){bf_lo(xv.x), bf_hi(xv.x), bf_lo(xv.y), bf_hi(xv.y)} * w0;
                c1 += (f32x4){bf_lo(xv.z), bf_hi(xv.z), bf_lo(xv.w), bf_hi(xv.w)} * w1;
            }
            u32x4 pk; pk.x = cvt_pk_bf16(c0[0], c0[1]); pk.y = cvt_pk_bf16(c0[2], c0[3]); pk.z = cvt_pk_bf16(c1[0], c1[1]); pk.w = cvt_pk_bf16(c1[2], c1[3]);
            bfrag[ks] = __builtin_bit_cast(bf16x8, pk);
            if (ks == 0 || ks == q) {
#pragma unroll
                for (int e = 0; e < 4; ++e) { own[e] = c0[e]; own[4 + e] = c1[e]; } }
        }
        f32x16 acc;
#pragma unroll
        for (int r = 0; r < 16; ++r) acc[r] = 0.f;
#pragma unroll
        for (int ks = 0; ks < 4; ++ks) acc = __builtin_amdgcn_mfma_f32_32x32x16_bf16(af[ks], bfrag[ks], acc, 0, 0, 0);
        u32x4 gv = (u32x4){0u, 0u, 0u, 0u};
        const size_t ooff = ((size_t)b * SEQ + t) * DM + n * 64 + q * 16 + hi * 8;
        if (WRITE) gv = *(const u32x4*)(GR + ooff);
        float outv[8];
#pragma unroll
        for (int j = 0; j < 8; ++j) {
            const float rg = sigm(acc[8 * (j >> 2) + (j & 3)] + br[j]), ig = sigm(acc[8 * (j >> 2) + 4 + (j & 3)] + bi[j]);
            const float la = -rg * sp8[j]; float av = __builtin_amdgcn_exp2f(la * 1.4426950408889634f);
            const float y = 2.0f * la, em = -y * (1.0f + y * 0.5f * (1.0f + y * (1.0f / 3.0f) * (1.0f + y * 0.25f * (1.0f + y * 0.2f * (1.0f + y * (1.0f / 6.0f))))));
            float bx = __builtin_amdgcn_sqrtf(em) * (ig * own[j]);
#pragma unroll
            for (int d = 1; d < 32; d <<= 1) { const float ap = __shfl_up(av, d, 32), bp = __shfl_up(bx, d, 32); if (r32 >= d) { bx = av * bp + bx; av = av * ap; } }
            const float hv = bx + av * Hc[j];
            Hc[j] = __shfl(hv, 31, 32);
            if (!WRITE) Ar[j] *= __shfl(av, 31, 32);
            outv[j] = hv;
        }
        if (WRITE) {
            u32x4 w;
            w.x = cvt_pk_bf16(outv[0] * bf_lo(gv.x), outv[1] * bf_hi(gv.x)); w.y = cvt_pk_bf16(outv[2] * bf_lo(gv.y), outv[3] * bf_hi(gv.y));
            w.z = cvt_pk_bf16(outv[4] * bf_lo(gv.z), outv[5] * bf_hi(gv.z)); w.w = cvt_pk_bf16(outv[6] * bf_lo(gv.w), outv[7] * bf_hi(gv.w));
            *(u32x4*)(OUT + ooff) = w;
        }
    }
}
__device__ __forceinline__ void rnn_item(const Args& a, LAS unsigned char* lds, int b, int n, int q, int tid, int wid, int lane) {
    const int r32 = lane & 31, hi = lane >> 5;
    const bf16* XR = (const bf16*)(a.ws + WS_XR); const bf16* GR = (const bf16*)(a.ws + WS_GR); bf16* OUT = (bf16*)(a.ws + WS_RNN);
    LAS float* CW = (LAS float*)(lds + RL_CW); LAS float* AGG = (LAS float*)(lds + RL_AGG);
    if (tid < 320) { const int c = tid & 7, tap = (tid >> 3) % 5, kh = tid / 40; const int ch = n * 64 + (kh >> 1) * 16 + (kh & 1) * 8 + c;
        CW[tid] = tap < 4 ? a.in[I_CW][tap * DM + ch] : a.in[I_CB][ch]; }
    bf16x8 af[4];
    { const int gate = (r32 >> 3) & 1, cl = 8 * ((r32 >> 2) & 1) + 4 * ((r32 >> 4) & 1) + (r32 & 3);
      const float* W = (gate ? a.in[I_WRI] : a.in[I_WRR]) + (size_t)n * 4096 + q * 16 + cl;
#pragma unroll
      for (int ks = 0; ks < 4; ++ks) { float v[8];
#pragma unroll
          for (int j = 0; j < 8; ++j) v[j] = W[(16 * ks + 8 * hi + j) * 64];
          u32x4 pk; pk.x = cvt_pk_bf16(v[0], v[1]); pk.y = cvt_pk_bf16(v[2], v[3]); pk.z = cvt_pk_bf16(v[4], v[5]); pk.w = cvt_pk_bf16(v[6], v[7]);
          af[ks] = __builtin_bit_cast(bf16x8, pk); } }
    float br[8], bi[8], sp8[8], Hc[8], Ar[8];
#pragma unroll
    for (int j = 0; j < 8; ++j) { const int ch = n * 64 + q * 16 + 8 * hi + j; br[j] = a.in[I_BRR][ch]; bi[j] = a.in[I_BRI][ch];
        const float lm = a.in[I_LAM][ch]; sp8[j] = 8.0f * (fmaxf(-lm, 0.f) + log1pf(__expf(-fabsf(lm)))); Hc[j] = 0.f; Ar[j] = 1.f; }
    __syncthreads();
    rnn_pass<false>(XR, GR, OUT, lds, af, br, bi, sp8, Hc, Ar, b, n, q, wid, lane);
    if (r32 == 0) {
#pragma unroll
        for (int j = 0; j < 8; ++j) { AGG[(wid * 16 + 8 * hi + j) * 2] = Ar[j]; AGG[(wid * 16 + 8 * hi + j) * 2 + 1] = Hc[j]; } }
    __syncthreads();
#pragma unroll
    for (int j = 0; j < 8; ++j) { float c = 0.f; for (int w = 0; w < wid; ++w) { const float A = AGG[(w * 16 + 8 * hi + j) * 2], Hh = AGG[(w * 16 + 8 * hi + j) * 2 + 1]; c = A * c + Hh; } Hc[j] = c; }
    rnn_pass<true>(XR, GR, OUT, lds, af, br, bi, sp8, Hc, Ar, b, n, q, wid, lane);
    __syncthreads();
}

__global__ void __launch_bounds__(512, 2) fwd_megakernel(Args a) {
    extern __shared__ __attribute__((aligned(16))) unsigned char lds_raw[];
    LAS unsigned char* lds = (LAS unsigned char*)lds_raw;
    cg::grid_group grid = cg::this_grid();
    const int tid = threadIdx.x, lane = tid & 63, wave = __builtin_amdgcn_readfirstlane(tid >> 6);
    const int G = gridDim.x, bx = blockIdx.x;
    const int vcu = (G % 8 == 0) ? (bx % 8) * (G / 8) + bx / 8 : bx;
    unsigned char* ws = a.ws;
    bf16* GA = (bf16*)a.out; bf16* GB = (bf16*)((unsigned char*)a.out + 32 * MiB); bf16* HB = (bf16*)a.out;

    p0_prologue(a, lds, vcu * 8 + wave, G * 8, wave, lane);
    __syncthreads();
    grid.sync();
    {   pg8::Gemm g{(const bf16*)(ws + WS_XN), (const bf16*)(ws + WS_WIN), M, NIN, DM}; pg8::StaticOrder S; S.init(M, NIN, G, bx);
        pg8::EpiIn E{(bf16*)(ws + WS_Q), (bf16*)(ws + WS_K), (bf16*)(ws + WS_V), (bf16*)(ws + WS_XR), (bf16*)(ws + WS_GR), GA, GB, a.in[I_BM]};
        pg8::gemm_phase<pg8::EpiIn, pg8::StaticOrder, true, true>(lds, g, S, E); }
    grid.sync();
    for (int it = vcu; it < NB * 16 * 4; it += G) rnn_item(a, lds, it >> 6, (it >> 2) & 15, it & 3, tid, wave, lane);
    for (int u = bx; u < 16 * NB * NH; u += G) { const int qg = u >> 6, bh = u & 63;
        attn_unit(lds, (const bf16*)(ws + WS_Q), (const bf16*)(ws + WS_K), (const bf16*)(ws + WS_V), (bf16*)(ws + WS_ATT), a.in[I_REL], bh >> 4, bh & 15, qg, tid, wave, lane); }
    grid.sync();
    {   pg8::StaticOrder S; S.init(M, DM, G, bx);
        { pg8::Gemm g{(const bf16*)(ws + WS_ATT), (const bf16*)(ws + WS_WAO), M, DM, DM}; pg8::EpiGateA E{GA, (float*)(ws + WS_T1)};
          pg8::gemm_phase<pg8::EpiGateA, pg8::StaticOrder, true, true>(lds, g, S, E); }
        { pg8::Gemm g{(const bf16*)(ws + WS_RNN), (const bf16*)(ws + WS_WRO), M, DM, DM}; pg8::EpiGateB E{GB, (const float*)(ws + WS_T1), (bf16*)(ws + WS_MIX)};
          pg8::gemm_phase<pg8::EpiGateB, pg8::StaticOrder, true, true>(lds, g, S, E); } }
    grid.sync();
    {   pg8::Gemm g{(const bf16*)(ws + WS_MIX), (const bf16*)(ws + WS_WO), M, DM, DM}; pg8::StaticOrder S; S.init(M, DM, G, bx);
        pg8::EpiResStats E{a.in[I_X], (float*)(ws + WS_H), HB, (float*)(ws + WS_SS1)};
        pg8::gemm_phase<pg8::EpiResStats, pg8::StaticOrder, false, true>(lds, g, S, E); }
    grid.sync();
    {   pg8::Gemm g{HB, (const bf16*)(ws + WS_WF1), M, 2 * DFF, DM}; pg8::StaticOrder S; S.init(M, 2 * DFF, G, bx);
        pg8::EpiSwiGLU E{(const float*)(ws + WS_SS1), (bf16*)(ws + WS_ACT), DFF};
        pg8::gemm_phase<pg8::EpiSwiGLU, pg8::StaticOrder, true, true>(lds, g, S, E); }
    grid.sync();
    {   pg8::Gemm g{(const bf16*)(ws + WS_ACT), (const bf16*)(ws + WS_WF2), M, DM, DFF}; pg8::StaticOrder S; S.init(M, DM, G, bx);
        pg8::EpiResStats E{(const float*)(ws + WS_H), a.out, nullptr, (float*)(ws + WS_SS2)};
        pg8::gemm_phase<pg8::EpiResStats, pg8::StaticOrder, false, true>(lds, g, S, E); }
    grid.sync();
    {   const float* ss = (const float*)(ws + WS_SS2); f32x4 gv[4];
#pragma unroll
        for (int j = 0; j < 4; ++j) gv[j] = *((const f32x4*)a.in[I_FNG] + lane + 64 * j);
        for (int m = vcu * 8 + wave; m < M; m += G * 8) {
            f32x4* xr = (f32x4*)(a.out + (size_t)m * DM) + lane; const f32x4 p = *(const f32x4*)(ss + (size_t)m * 4);
            const float rstd = __builtin_amdgcn_rsqf(((p[0] + p[1]) + (p[2] + p[3])) * (1.f / DM) + 1e-6f);
#pragma unroll
            for (int j = 0; j < 4; ++j) { f32x4 v = xr[64 * j]; xr[64 * j] = v * rstd * gv[j]; }
        } }
}

extern "C" void kernel_launch(void* const* d_in, const int* in_sizes, int n_in, void* d_out, int out_size, void* d_ws, size_t ws_size, hipStream_t stream) {
    static int grid = 0;
    if (grid == 0) {
        if (n_in != 19 || in_sizes[0] != M * DM || out_size != M * DM || ws_size < WS_END) { fprintf(stderr, "kernel_launch: unexpected shapes (n_in %d, in0 %d, out %d, ws %zu)\n", n_in, n_in > 0 ? in_sizes[0] : -1, out_size, ws_size); grid = -1; return; }
        int dev = 0, cus = 0, per_cu = 0;
        hipGetDevice(&dev); hipDeviceGetAttribute(&cus, hipDeviceAttributeMultiprocessorCount, dev);
        if (hipFuncSetAttribute((const void*)fwd_megakernel, hipFuncAttributeMaxDynamicSharedMemorySize, LDS_BYTES) != hipSuccess) { fprintf(stderr, "kernel_launch: hipFuncSetAttribute failed\n"); grid = -1; return; }
        hipOccupancyMaxActiveBlocksPerMultiprocessor(&per_cu, (const void*)fwd_megakernel, 512, LDS_BYTES);
        (void)hipGetLastError();
        if (per_cu < 1) per_cu = 1;
        grid = cus;
        if (grid != 256) fprintf(stderr, "kernel_launch: %d CUs, expected 256\n", grid);
    }
    if (grid < 0) return;
    Args a{};
    for (int i = 0; i < 19; ++i) a.in[i] = (const float*)d_in[i];
    a.out = (float*)d_out; a.ws = (unsigned char*)d_ws;
    void* args[] = {&a};
    hipError_t e = hipLaunchCooperativeKernel((const void*)fwd_megakernel, dim3(grid), dim3(512), args, LDS_BYTES, stream);
    if (e != hipSuccess) fprintf(stderr, "cooperative launch failed: %s (grid %d)\n", hipGetErrorString(e), grid);
}
```

```cpp
#define PROBE 0
#include <hip/hip_runtime.h>
#include <hip/hip_cooperative_groups.h>
#include <cstdio>
#include <cstdint>
namespace cg = cooperative_groups;
namespace pg8 {
#define PG8_LAS __attribute__((address_space(3)))
typedef unsigned short bf16_t;
typedef short bf16x8 __attribute__((ext_vector_type(8)));
typedef float f32x4 __attribute__((ext_vector_type(4)));
typedef unsigned u32x4 __attribute__((ext_vector_type(4)));
constexpr int BM = 256, BK = 64, HALF = 128, HTB = HALF * BK * 2  , STAGE_BYTES = 8 * HTB, NXCD = 8, WGM = 8;

__host__ __device__ __forceinline__ int lds_byte(int r, int c) { const int st = (r >> 4) * 2 + (c >> 5), rr = r & 15, cc = c & 31, ob = rr * 64 + cc * 2; return st * 1024 + (ob ^ (((ob >> 9) & 1) << 5)); }
__host__ __device__ __forceinline__ void stage_rc(int b, int& R, int& C) { const int st = b / 1024, sb = b % 1024, swz = sb ^ (((sb >> 9) & 1) << 5); R = (st >> 1) * 16 + swz / 64; C = (st & 1) * 32 + (swz % 64) / 2; }
__host__ __device__ __forceinline__ int perm32(int rho) { const int n = rho >> 4, i = rho & 15; return 8 * (i >> 2) + 4 * n + (i & 3); }

struct Unit { int pm, pn; };
struct Gemm { const bf16_t* A; const bf16_t* Bt; int M, N, K; };

struct StaticOrder {
    int nM, nN, nwg, G, c;
    __host__ __device__ void init(int M, int N, int G_, int c_) { nM = M / BM; nN = N / BM; nwg = nM * nN; G = G_; c = c_; }
    __host__ __device__ bool next(int i, Unit& u) const {
        const long L = (long)i * G + c; if (L >= nwg) return false;
        int wgid = (int)L; { const int q = nwg / NXCD, r = nwg % NXCD, xcd = wgid % NXCD, off = wgid / NXCD; wgid = (xcd < r ? xcd * (q + 1) : r * (q + 1) + (xcd - r) * q) + off; }
        const int nig = WGM * nN, gid = wgid / nig, fm = gid * WGM, gsz = (nM - fm) < WGM ? (nM - fm) : WGM;
        u.pm = fm + ((wgid % nig) % gsz); u.pn = (wgid % nig) / gsz; return true;
    }
    __device__ __forceinline__ void a_ready(const Unit&) const {}
    __device__ __forceinline__ void done(const Unit&) const {}
};

__device__ __forceinline__ unsigned cvt_pk_bf16(float lo, float hi) { unsigned r; asm volatile("v_cvt_pk_bf16_f32 %0, %1, %2" : "=v"(r) : "v"(lo), "v"(hi)); return r; }
typedef float f32x2 __attribute__((ext_vector_type(2)));
__device__ __forceinline__ float sigm(float x) { return __builtin_amdgcn_rcpf(1.0f + __builtin_amdgcn_exp2f(-1.4426950408889634f * x)); }
__device__ __forceinline__ float gelu_t(float x) { return x * sigm(x * (1.5957691216057308f + 0.07135481627159855f * x * x)); }
__device__ __forceinline__ float bf_lo(unsigned w) { return __uint_as_float(w << 16); }
__device__ __forceinline__ float bf_hi(unsigned w) { return __uint_as_float(w & 0xffff0000u); }

struct EpiIn {
    static constexpr bool PERM = true, AFTER_DRAIN = false;
    bf16_t *Q, *K, *V, *XR, *GR, *GA, *GB; const float* bm;
    __device__ __forceinline__ void operator()(const f32x4 (&acc)[2][2][4][2], const Unit& u, int wr, int wc, int fr, int fq) const {
        const int t = u.pn >> 2;
        bf16_t* base = t == 0 ? Q : t == 1 ? K : t == 2 ? V : t == 3 ? XR : t == 4 ? GR : t == 5 ? GA : GB;
        const int col0 = (u.pn & 3) * 256 + wc * 32 + 8 * fq;
        const int row0 = u.pm * BM + wr * 64 + fr;
        f32x4 bv[2][2];
#pragma unroll
        for (int bj = 0; bj < 2; ++bj)
#pragma unroll
            for (int n = 0; n < 2; ++n) bv[bj][n] = (t >= 5) ? *(const f32x4*)(bm + (t - 5) * 1024 + col0 + bj * HALF + 4 * n) : (f32x4){0.f, 0.f, 0.f, 0.f};
#pragma unroll
        for (int ai = 0; ai < 2; ++ai)
#pragma unroll
            for (int m = 0; m < 4; ++m) { bf16_t* rowp = base + (size_t)(row0 + ai * HALF + m * 16) * 1024 + col0;
#pragma unroll
                for (int bj = 0; bj < 2; ++bj) { f32x4 v0 = acc[ai][bj][m][0] + bv[bj][0], v1 = acc[ai][bj][m][1] + bv[bj][1];
                    if (t == 0) { v0 = v0 * 0.125f; v1 = v1 * 0.125f; }
                    else if (t == 4) { v0 = (f32x4){gelu_t(v0[0]), gelu_t(v0[1]), gelu_t(v0[2]), gelu_t(v0[3])}; v1 = (f32x4){gelu_t(v1[0]), gelu_t(v1[1]), gelu_t(v1[2]), gelu_t(v1[3])}; }
                    else if (t >= 5) { v0 = (f32x4){sigm(v0[0]), sigm(v0[1]), sigm(v0[2]), sigm(v0[3])}; v1 = (f32x4){sigm(v1[0]), sigm(v1[1]), sigm(v1[2]), sigm(v1[3])}; }
                    u32x4 w; w.x = cvt_pk_bf16(v0[0], v0[1]); w.y = cvt_pk_bf16(v0[2], v0[3]); w.z = cvt_pk_bf16(v1[0], v1[1]); w.w = cvt_pk_bf16(v1[2], v1[3]);
                    *(u32x4*)(rowp + bj * HALF) = w; } }
    }
};

struct EpiGateA {
    static constexpr bool PERM = true, AFTER_DRAIN = false;
    const bf16_t* G; float* T;
    __device__ __forceinline__ void operator()(const f32x4 (&acc)[2][2][4][2], const Unit& u, int wr, int wc, int fr, int fq) const {
        const int col0 = u.pn * BM + wc * 32 + 8 * fq, row0 = u.pm * BM + wr * 64 + fr;
#pragma unroll
        for (int ai = 0; ai < 2; ++ai)
#pragma unroll
            for (int m = 0; m < 4; ++m) { const size_t off = (size_t)(row0 + ai * HALF + m * 16) * 1024 + col0;
#pragma unroll
                for (int bj = 0; bj < 2; ++bj) { const u32x4 g = *(const u32x4*)(G + off + bj * HALF);
                    const f32x4 a0 = acc[ai][bj][m][0], a1 = acc[ai][bj][m][1];
                    *(f32x4*)(T + off + bj * HALF) = (f32x4){a0[0] * bf_lo(g.x), a0[1] * bf_hi(g.x), a0[2] * bf_lo(g.y), a0[3] * bf_hi(g.y)};
                    *(f32x4*)(T + off + bj * HALF + 4) = (f32x4){a1[0] * bf_lo(g.z), a1[1] * bf_hi(g.z), a1[2] * bf_lo(g.w), a1[3] * bf_hi(g.w)}; } }
    }
};
struct EpiGateB {
    static constexpr bool PERM = true, AFTER_DRAIN = false;
    const bf16_t* G; const float* T; bf16_t* O;
    __device__ __forceinline__ void operator()(const f32x4 (&acc)[2][2][4][2], const Unit& u, int wr, int wc, int fr, int fq) const {
        const int col0 = u.pn * BM + wc * 32 + 8 * fq, row0 = u.pm * BM + wr * 64 + fr;
#pragma unroll
        for (int ai = 0; ai < 2; ++ai)
#pragma unroll
            for (int m = 0; m < 4; ++m) { const size_t off = (size_t)(row0 + ai * HALF + m * 16) * 1024 + col0;
#pragma unroll
                for (int bj = 0; bj < 2; ++bj) { const u32x4 g = *(const u32x4*)(G + off + bj * HALF);
                    const f32x4 t0 = *(const f32x4*)(T + off + bj * HALF), t1 = *(const f32x4*)(T + off + bj * HALF + 4);
                    const f32x4 a0 = acc[ai][bj][m][0], a1 = acc[ai][bj][m][1];
                    u32x4 w; w.x = cvt_pk_bf16(t0[0] + a0[0] * bf_lo(g.x), t0[1] + a0[1] * bf_hi(g.x)); w.y = cvt_pk_bf16(t0[2] + a0[2] * bf_lo(g.y), t0[3] + a0[3] * bf_hi(g.y));
                    w.z = cvt_pk_bf16(t1[0] + a1[0] * bf_lo(g.z), t1[1] + a1[1] * bf_hi(g.z)); w.w = cvt_pk_bf16(t1[2] + a1[2] * bf_lo(g.w), t1[3] + a1[3] * bf_hi(g.w));
                    *(u32x4*)(O + off + bj * HALF) = w; } }
    }
};
struct EpiResStats {
    static constexpr bool PERM = true, AFTER_DRAIN = true;
    const float* base; float* out; bf16_t* outb; float* ss;
    __device__ __forceinline__ void fused(f32x4 (&acc)[2][2][4][2], const Unit& u, int wr, int wc, int fr, int fq, PG8_LAS unsigned char* lds, int wid, int lane) const {
        PG8_LAS float* P = (PG8_LAS float*)lds;
        const int col0 = u.pn * BM + wc * 32 + 8 * fq, row0 = u.pm * BM + wr * 64 + fr;
#pragma unroll
        for (int ai = 0; ai < 2; ++ai)
#pragma unroll
            for (int m = 0; m < 4; ++m) { const size_t off = (size_t)(row0 + ai * HALF + m * 16) * 1024 + col0; float s = 0.f;
#pragma unroll
                for (int bj = 0; bj < 2; ++bj) {
                    const f32x4 h0 = *(const f32x4*)(base + off + bj * HALF) + acc[ai][bj][m][0], h1 = *(const f32x4*)(base + off + bj * HALF + 4) + acc[ai][bj][m][1];
                    *(f32x4*)(out + off + bj * HALF) = h0; *(f32x4*)(out + off + bj * HALF + 4) = h1;
                    if (outb) { u32x4 w; w.x = cvt_pk_bf16(h0[0], h0[1]); w.y = cvt_pk_bf16(h0[2], h0[3]); w.z = cvt_pk_bf16(h1[0], h1[1]); w.w = cvt_pk_bf16(h1[2], h1[3]); *(u32x4*)(outb + off + bj * HALF) = w; }
                    s += (h0[0] * h0[0] + h0[1] * h0[1]) + (h0[2] * h0[2] + h0[3] * h0[3]) + (h1[0] * h1[0] + h1[1] * h1[1]) + (h1[2] * h1[2] + h1[3] * h1[3]); }
                s += __shfl_xor(s, 16); s += __shfl_xor(s, 32);
                if (fq == 0) P[(ai * HALF + wr * 64 + m * 16 + fr) * 4 + wc] = s; }
        __syncthreads();
        const int tid = wid * 64 + lane;
        if (tid < 256) { const f32x4 p = *(const PG8_LAS f32x4*)(P + tid * 4); ss[(size_t)(u.pm * BM + tid) * 4 + u.pn] = (p[0] + p[1]) + (p[2] + p[3]); }
        __syncthreads();
    }
};
struct EpiSwiGLU {
    static constexpr bool PERM = true, AFTER_DRAIN = false;
    const float* ss; bf16_t* O; int ldo;
    __device__ __forceinline__ void operator()(const f32x4 (&acc)[2][2][4][2], const Unit& u, int wr, int wc, int fr, int fq) const {
        const int col0 = u.pn * HALF + wc * 32 + 8 * fq, row0 = u.pm * BM + wr * 64 + fr;
#pragma unroll
        for (int ai = 0; ai < 2; ++ai)
#pragma unroll
            for (int m = 0; m < 4; ++m) { const int row = row0 + ai * HALF + m * 16; const f32x4 p = *(const f32x4*)(ss + (size_t)row * 4);
                const float rstd = __builtin_amdgcn_rsqf(((p[0] + p[1]) + (p[2] + p[3])) * (1.0f / 1024.0f) + 1e-6f);
                float r[8];
#pragma unroll
                for (int n = 0; n < 2; ++n)
#pragma unroll
                    for (int e = 0; e < 4; ++e) { const float g = acc[ai][0][m][n][e] * rstd, up = acc[ai][1][m][n][e] * rstd; r[n * 4 + e] = g * sigm(g) * up; }
                u32x4 w; w.x = cvt_pk_bf16(r[0], r[1]); w.y = cvt_pk_bf16(r[2], r[3]); w.z = cvt_pk_bf16(r[4], r[5]); w.w = cvt_pk_bf16(r[6], r[7]);
                *(u32x4*)(O + (size_t)row * ldo + col0) = w; }
    }
};

template <class Epi, class Sched, bool ALIGN_EPI = false, bool SP2 = false>
__device__ __forceinline__ void gemm_phase(PG8_LAS unsigned char* lds, const Gemm g, const Sched& S, const Epi& E) {
    const int tid = threadIdx.x, wid = __builtin_amdgcn_readfirstlane(tid >> 6), lane = tid & 63, wr = wid >> 2, wc = wid & 3, fr = lane & 15, fq = lane >> 4;
    const int K = g.K, nt = K / BK;
    unsigned voffA[2], voffB[2];
#pragma unroll
    for (int i = 0; i < 2; ++i) { int R, C; stage_rc(tid * 16 + i * 8192, R, C); const int Rb = Epi::PERM ? ((R & ~31) + perm32(R & 31)) : R;
        voffA[i] = (unsigned)(R * K + C) * 2u; voffB[i] = (unsigned)(Rb * K + C) * 2u; }
    const size_t kstep = (size_t)(BK * 2);
    const size_t hstep = (size_t)HALF * K * 2;
    const size_t tstep = 2 * hstep;
    const unsigned ldsw = (unsigned)wid * 1024u;
    const int aoff = lds_byte(wr * 64 + fr, fq * 8), boff = lds_byte(wc * 32 + fr, fq * 8);
#define PG8_SA(b, h) (((b) * 2 + (h)) * HTB)
#define PG8_SB(b, h) ((4 + (b) * 2 + (h)) * HTB)
#define PG8_STAGE(bufoff, gbase, voff) do { _Pragma("unroll") for (int _i = 0; _i < 2; ++_i) \
        __builtin_amdgcn_global_load_lds((const unsigned*)((const char*)(gbase) + (voff)[_i]), (PG8_LAS unsigned*)(lds + (bufoff) + ldsw + _i * 8192), 16, 0, 0); } while (0)
#define PG8_LDA(dst, b, h) do { _Pragma("unroll") for (int m = 0; m < 4; ++m) _Pragma("unroll") for (int k = 0; k < 2; ++k) dst[m][k] = *(const PG8_LAS bf16x8*)(lds + PG8_SA(b, h) + aoff + m * 2048 + k * 1024); } while (0)
#define PG8_LDB(dst, b, h) do { _Pragma("unroll") for (int n = 0; n < 2; ++n) _Pragma("unroll") for (int k = 0; k < 2; ++k) dst[n][k] = *(const PG8_LAS bf16x8*)(lds + PG8_SB(b, h) + boff + n * 2048 + k * 1024); } while (0)
#define PG8_MMA(ai, bj, At, Bt) do { __builtin_amdgcn_s_setprio(1); _Pragma("unroll") for (int m = 0; m < 4; ++m) _Pragma("unroll") for (int n = 0; n < 2; ++n) _Pragma("unroll") for (int k = 0; k < 2; ++k) \
        acc[ai][bj][m][n] = __builtin_amdgcn_mfma_f32_16x16x32_bf16(Bt[n][k], At[m][k], acc[ai][bj][m][n], 0, 0, 0); __builtin_amdgcn_s_setprio(0); } while (0)
#define PG8_WAIT_V(n) asm volatile("s_waitcnt vmcnt(" #n ")" ::: "memory")
#define PG8_WAIT_L(n) asm volatile("s_waitcnt lgkmcnt(" #n ")" ::: "memory")
#define PG8_BAR __builtin_amdgcn_s_barrier()
#define PG8_SCHED __builtin_amdgcn_sched_barrier(0)
    Unit cur, nxt; int ui = 0;
    if (!S.next(0, cur)) return;
    f32x4 acc[2][2][4][2];
#pragma unroll
    for (int a = 0; a < 2; ++a)
#pragma unroll
        for (int b = 0; b < 2; ++b)
#pragma unroll
            for (int m = 0; m < 4; ++m)
#pragma unroll
                for (int n = 0; n < 2; ++n) acc[a][b][m][n] = (f32x4){0.f, 0.f, 0.f, 0.f};
    bf16x8 At[4][2], B0[2][2], B1[2][2];
    const char* cA = (const char*)g.A + (size_t)cur.pm * tstep; const char* cB = (const char*)g.Bt + (size_t)cur.pn * tstep;
    S.a_ready(cur);
    if constexpr (SP2) {
        PG8_STAGE(PG8_SB(0, 0), cB, voffB); PG8_STAGE(PG8_SB(0, 1), cB + hstep, voffB); PG8_STAGE(PG8_SA(0, 0), cA, voffA); PG8_STAGE(PG8_SA(0, 1), cA + hstep, voffA);
        if (wr == 1) PG8_BAR;
        PG8_WAIT_V(2); PG8_BAR;
        PG8_STAGE(PG8_SB(1, 0), cB + kstep, voffB); PG8_STAGE(PG8_SA(1, 0), cA + kstep, voffA); PG8_STAGE(PG8_SB(1, 1), cB + hstep + kstep, voffB);
        PG8_WAIT_V(6); PG8_BAR;
    } else {
        PG8_STAGE(PG8_SB(0, 0), cB, voffB); PG8_STAGE(PG8_SA(0, 0), cA, voffA); PG8_STAGE(PG8_SB(0, 1), cB + hstep, voffB); PG8_STAGE(PG8_SA(0, 1), cA + hstep, voffA);
        if (wr == 1) PG8_BAR;
        PG8_WAIT_V(4); PG8_BAR;
        PG8_STAGE(PG8_SB(1, 0), cB + kstep, voffB); PG8_STAGE(PG8_SA(1, 0), cA + kstep, voffA); PG8_STAGE(PG8_SB(1, 1), cB + hstep + kstep, voffB);
        PG8_WAIT_V(6); PG8_BAR;
    }
    for (;;) {
        const bool has_next = S.next(ui + 1, nxt);
        const char* nA = has_next ? (const char*)g.A + (size_t)nxt.pm * tstep : cA; const char* nB = has_next ? (const char*)g.Bt + (size_t)nxt.pn * tstep : cB;
        for (int t = 0; t < nt; t += 2) {
            const bool last = (t == nt - 2);
            const char* a1 = cA + (size_t)(t + 1) * kstep;
            const char* a2 = last ? nA : cA + (size_t)(t + 2) * kstep; const char* b2 = last ? nB : cB + (size_t)(t + 2) * kstep;
            const char* a3 = a2 + kstep; const char* b3 = b2 + kstep;
            if (last && has_next) S.a_ready(nxt);
            if constexpr (SP2) {
            PG8_LDB(B0, 0, 0); PG8_LDB(B1, 0, 1); PG8_SCHED; PG8_LDA(At, 0, 0); PG8_STAGE(PG8_SA(1, 1), a1 + hstep, voffA);
            PG8_WAIT_V(8); PG8_WAIT_L(0); PG8_BAR; PG8_MMA(0, 0, At, B0); PG8_MMA(0, 1, At, B1); PG8_BAR; PG8_SCHED;
            PG8_LDA(At, 0, 1); PG8_STAGE(PG8_SB(0, 0), b2, voffB); PG8_STAGE(PG8_SB(0, 1), b2 + hstep, voffB); PG8_STAGE(PG8_SA(0, 0), a2, voffA);
            PG8_WAIT_V(8); PG8_WAIT_L(0); PG8_BAR; PG8_MMA(1, 0, At, B0); PG8_MMA(1, 1, At, B1); PG8_BAR; PG8_SCHED;
            PG8_LDB(B0, 1, 0); PG8_LDB(B1, 1, 1); PG8_SCHED; PG8_LDA(At, 1, 0); PG8_STAGE(PG8_SA(0, 1), a2 + hstep, voffA);
            PG8_WAIT_V(8); PG8_WAIT_L(0); PG8_BAR; PG8_MMA(0, 0, At, B0); PG8_MMA(0, 1, At, B1); PG8_BAR; PG8_SCHED;
            PG8_LDA(At, 1, 1); PG8_STAGE(PG8_SB(1, 0), b3, voffB); PG8_STAGE(PG8_SB(1, 1), b3 + hstep, voffB); PG8_STAGE(PG8_SA(1, 0), a3, voffA);
            PG8_WAIT_V(8); PG8_WAIT_L(0); PG8_BAR; PG8_MMA(1, 0, At, B0); PG8_MMA(1, 1, At, B1); PG8_BAR; PG8_SCHED;
            } else {
            PG8_LDB(B0, 0, 0); PG8_SCHED; PG8_LDA(At, 0, 0); PG8_STAGE(PG8_SA(1, 1), a1 + hstep, voffA);
            PG8_WAIT_L(8); PG8_BAR; PG8_WAIT_L(0); PG8_MMA(0, 0, At, B0); PG8_BAR; PG8_SCHED;
            PG8_LDB(B1, 0, 1); PG8_STAGE(PG8_SB(0, 0), b2, voffB);
            PG8_BAR; PG8_WAIT_L(0); PG8_MMA(0, 1, At, B1); PG8_BAR;
            PG8_LDA(At, 0, 1); PG8_STAGE(PG8_SA(0, 0), a2, voffA);
            PG8_BAR; PG8_WAIT_L(0); PG8_MMA(1, 0, At, B0); PG8_BAR; PG8_SCHED;
            PG8_STAGE(PG8_SB(0, 1), b2 + hstep, voffB);
            PG8_WAIT_V(6); PG8_BAR; PG8_MMA(1, 1, At, B1); PG8_BAR;
            PG8_LDB(B0, 1, 0); PG8_SCHED; PG8_LDA(At, 1, 0); PG8_STAGE(PG8_SA(0, 1), a2 + hstep, voffA);
            PG8_WAIT_L(8); PG8_BAR; PG8_WAIT_L(0); PG8_MMA(0, 0, At, B0); PG8_BAR; PG8_SCHED;
            PG8_LDB(B1, 1, 1); PG8_STAGE(PG8_SB(1, 0), b3, voffB);
            PG8_BAR; PG8_WAIT_L(0); PG8_MMA(0, 1, At, B1); PG8_BAR;
            PG8_LDA(At, 1, 1); PG8_STAGE(PG8_SA(1, 0), a3, voffA);
            PG8_BAR; PG8_WAIT_L(0); PG8_MMA(1, 0, At, B0); PG8_BAR; PG8_SCHED;
            PG8_STAGE(PG8_SB(1, 1), b3 + hstep, voffB);
            PG8_WAIT_V(6); PG8_BAR; PG8_MMA(1, 1, At, B1); PG8_BAR;
            }
        }
        if constexpr (ALIGN_EPI) { if (wr == 0) PG8_BAR; }
        if constexpr (!Epi::AFTER_DRAIN) { E(acc, cur, wr, wc, fr, fq); S.done(cur); }
        if (!has_next) break;
#pragma unroll
        for (int a = 0; a < 2; ++a)
#pragma unroll
            for (int b = 0; b < 2; ++b)
#pragma unroll
                for (int m = 0; m < 4; ++m)
#pragma unroll
                    for (int n = 0; n < 2; ++n) acc[a][b][m][n] = (f32x4){0.f, 0.f, 0.f, 0.f};
        cur = nxt; cA = nA; cB = nB; ++ui;
        if constexpr (ALIGN_EPI) { if (wr == 1) PG8_BAR; }
    }
    PG8_WAIT_V(0);
    if constexpr (!ALIGN_EPI) { if (wr == 0) PG8_BAR; }
    PG8_BAR;
    if constexpr (Epi::AFTER_DRAIN) { E.fused(acc, cur, wr, wc, fr, fq, lds, wid, lane); S.done(cur); }
#undef PG8_SA
#undef PG8_SB
#undef PG8_STAGE
#undef PG8_LDA
#undef PG8_LDB
#undef PG8_MMA
#undef PG8_WAIT_V
#undef PG8_WAIT_L
#undef PG8_BAR
#undef PG8_SCHED
}
}

#ifndef PROBE
#define PROBE 0
#endif
constexpr int NB = 4, SEQ = 4096, DM = 1024, NH = 16, M = NB * SEQ, NIN = 7 * 1024, DFF = 2816;
constexpr size_t MiB = 1u << 20;
constexpr size_t WS_WIN = 2 * MiB, WS_WAO = 16 * MiB, WS_WRO = 18 * MiB, WS_WO = 20 * MiB, WS_WF1 = 22 * MiB, WS_WF2 = 33 * MiB;
constexpr size_t WS_SS1 = 40 * MiB, WS_SS2 = 41 * MiB;
constexpr size_t WS_Q = 44 * MiB, WS_K = 76 * MiB, WS_V = 108 * MiB, WS_XR = 140 * MiB, WS_GR = 172 * MiB, WS_XN = 204 * MiB;
constexpr size_t WS_ATT = WS_XN;
constexpr size_t WS_RNN = WS_GR;
constexpr size_t WS_T1 = WS_K;
constexpr size_t WS_MIX = WS_Q;
constexpr size_t WS_H = WS_K;
constexpr size_t WS_ACT = WS_XR;
constexpr size_t WS_END = 236 * MiB;

constexpr int LDS_BYTES = 131072 + 4096 + 256;
constexpr int MISC_OFF = 131072 + 4096;
constexpr size_t WS_CTL = 0, CTL_ZERO_BYTES = 65536;
#define LAS __attribute__((address_space(3)))
typedef unsigned short bf16;
typedef unsigned u32x4 __attribute__((ext_vector_type(4)));
typedef unsigned u32x2 __attribute__((ext_vector_type(2)));
typedef float f32x4 __attribute__((ext_vector_type(4)));
typedef float f32x16 __attribute__((ext_vector_type(16)));
typedef short bf16x8 __attribute__((ext_vector_type(8)));
typedef short v4i16_t __attribute__((ext_vector_type(4)));
using pg8::cvt_pk_bf16; using pg8::sigm; using pg8::gelu_t; using pg8::bf_lo; using pg8::bf_hi;

#define XB_TMO      128
#define XB_XCNT(j)  (256  + 64 * (j))
#define XB_XSUB(j)  (1280 + 64 * (j))
#define XB_XGEN(j)  (2304 + 64 * (j))
#define XB_TOP      3328
#define XB_TOPGEN   3392
#define XCD_BAR_WORDS 3456
#define XB_SPIN_CAP (1u << 18)

__device__ __forceinline__ unsigned xb_ld(unsigned* p)              { return __hip_atomic_load(p, __ATOMIC_RELAXED, __HIP_MEMORY_SCOPE_AGENT); }
__device__ __forceinline__ unsigned xb_add(unsigned* p, unsigned v) { return __hip_atomic_fetch_add(p, v, __ATOMIC_RELAXED, __HIP_MEMORY_SCOPE_AGENT); }
__device__ __forceinline__ unsigned xb_xcc_id() { return (unsigned)__builtin_amdgcn_s_getreg((3 << 11) | 20) & 0xFu; }
#define XB_SPIN(cond, bar) do { unsigned _sp = 0; while (cond) { __builtin_amdgcn_s_sleep(1); \
    if ((++_sp & 255u) == 0u) { if (xb_ld(&(bar)[XB_TMO])) break; if (_sp > XB_SPIN_CAP) { atomicAdd(&(bar)[XB_TMO], 1u); break; } } } } while (0)

struct XcdBarrier {
    unsigned* bar; unsigned x;
    volatile LAS unsigned* st;
};

__device__ __forceinline__ XcdBarrier xcd_barrier_post(unsigned* bar, volatile LAS unsigned* st) {
    XcdBarrier b; b.bar = bar; b.x = xb_xcc_id(); b.st = st;
    if (threadIdx.x == 0) (void)xb_add(&bar[XB_XCNT(b.x)], 1u);
    return b;
}
__device__ __forceinline__ void xcd_barrier_complete(unsigned* bar, unsigned x, unsigned& nloc, unsigned& nx) {
    const unsigned G = gridDim.x * gridDim.y * gridDim.z;
    unsigned sum, cnt, mine, sp = 0u;
    for (;;) {
        sum = 0u; cnt = 0u; mine = 0u;
#pragma unroll
        for (unsigned j = 0; j < 16; ++j) { const unsigned c = xb_ld(&bar[XB_XCNT(j)]); sum += c; cnt += (c > 0u) ? 1u : 0u; mine = (j == x) ? c : mine; }
        if (sum == G) break;
        __builtin_amdgcn_s_sleep(1);
        if ((++sp & 255u) == 0u) { if (xb_ld(&bar[XB_TMO])) break; if (sp > XB_SPIN_CAP) { atomicAdd(&bar[XB_TMO], 1u); break; } }
    }
    nloc = mine > 0u ? mine : 1u; nx = cnt > 0u ? cnt : 1u;
}

__device__ __forceinline__ void xcd_barrier(const XcdBarrier& b) {
    asm volatile("s_waitcnt vmcnt(0)" ::: "memory");
    __syncthreads();
    if (threadIdx.x == 0) {
        unsigned* bar = b.bar;
        __builtin_amdgcn_s_waitcnt(0);
        unsigned nloc = b.st[0], nx = b.st[1];
        if (nloc == 0u) { xcd_barrier_complete(bar, b.x, nloc, nx); b.st[0] = nloc; b.st[1] = nx; }
        const unsigned old = xb_add(&bar[XB_XSUB(b.x)], 1u);
        const unsigned gen = old / nloc;
        if (old + 1u == (gen + 1u) * nloc) {
            __builtin_amdgcn_fence(__ATOMIC_RELEASE, "agent");
            asm volatile("s_waitcnt vmcnt(0)" ::: "memory");
            const unsigned og = xb_add(&bar[XB_TOP], 1u);
            const unsigned tg = og / nx;
            if (og + 1u == (tg + 1u) * nx) xb_add(&bar[XB_TOPGEN], 1u);
            else XB_SPIN(xb_ld(&bar[XB_TOPGEN]) == tg, bar);
            __builtin_amdgcn_fence(__ATOMIC_ACQUIRE, "agent");
            xb_add(&bar[XB_XGEN(b.x)], 1u);
            asm volatile("s_waitcnt vmcnt(0)" ::: "memory");
        } else {
            XB_SPIN(xb_ld(&bar[XB_XGEN(b.x)]) == gen, bar);
            __builtin_amdgcn_fence(__ATOMIC_ACQUIRE, "agent");
            asm volatile("s_waitcnt vmcnt(0)" ::: "memory");
        }
    }
    __syncthreads();
}

__device__ __forceinline__ float wave_sum(float v) {
#pragma unroll
    for (int o = 1; o < 64; o <<= 1) v += __shfl_xor(v, o);
    return v;
}
__device__ __forceinline__ void transpose_item(const float* W, int K, int N, bf16* WT, int k0, int n0, int drow0, const float* kscale, LAS float* scr, int lane) {
#pragma unroll 8
    for (int i = 0; i < 32; ++i) { const int kk = 2 * i + (lane >> 5); float v = W[(size_t)(k0 + kk) * N + n0 + (lane & 31)]; if (kscale) v *= kscale[k0 + kk]; scr[kk * 33 + (lane & 31)] = v; }
    asm volatile("s_waitcnt lgkmcnt(0)" ::: "memory");
    const int c = lane & 7;
#pragma unroll
    for (int j = 0; j < 4; ++j) { const int n = (lane >> 3) + 8 * j; const LAS float* s = scr + (8 * c) * 33 + n;
        u32x4 o; o.x = cvt_pk_bf16(s[0 * 33], s[1 * 33]); o.y = cvt_pk_bf16(s[2 * 33], s[3 * 33]); o.z = cvt_pk_bf16(s[4 * 33], s[5 * 33]); o.w = cvt_pk_bf16(s[6 * 33], s[7 * 33]);
        *(u32x4*)(WT + (size_t)(drow0 + n) * K + k0 + 8 * c) = o; }
    asm volatile("s_waitcnt lgkmcnt(0)" ::: "memory");
}

struct Args { const float* in[19]; float* out; unsigned char* ws; };
enum { I_X = 0, I_NMG, I_WIN, I_BM, I_REL, I_WAO, I_CW, I_CB, I_WRR, I_BRR, I_WRI, I_BRI, I_LAM, I_WRO, I_WO, I_NFG, I_WF1, I_WF2, I_FNG };

__device__ __forceinline__ void p0_prologue(const Args& a, LAS unsigned char* lds, int gw, int NGW, int wave, int lane) {
    LAS float* scr = (LAS float*)(lds + wave * 16384);
    unsigned char* ws = a.ws;
    constexpr int I_IN = 16 * (NIN / 32), I_SQ = 16 * 32, I_F1 = 16 * (2 * DFF / 32), I_F2 = (DFF / 64) * 32;
    constexpr int NITEMS = I_IN + 3 * I_SQ + I_F1 + I_F2;
    for (int it = gw; it < NITEMS; it += NGW) {
        int r = it;
        if (r < I_IN) { const int nb = NIN / 32, kb = r / nb, n0 = (r % nb) * 32; transpose_item(a.in[I_WIN], DM, NIN, (bf16*)(ws + WS_WIN), kb * 64, n0, n0, nullptr, scr, lane); continue; } r -= I_IN;
        if (r < 3 * I_SQ) { const int w = r / I_SQ; r -= w * I_SQ; const int kb = r / 32, n0 = (r % 32) * 32;
            const float* W = w == 0 ? a.in[I_WAO] : w == 1 ? a.in[I_WRO] : a.in[I_WO]; bf16* D = (bf16*)(ws + (w == 0 ? WS_WAO : w == 1 ? WS_WRO : WS_WO));
            transpose_item(W, DM, DM, D, kb * 64, n0, n0, nullptr, scr, lane); continue; } r -= 3 * I_SQ;
        if (r < I_F1) { const int nb = 2 * DFF / 32, kb = r / nb, n0 = (r % nb) * 32; const int half = n0 / DFF, jj = n0 % DFF, drow = (jj / 128) * 256 + half * 128 + (jj % 128);
            transpose_item(a.in[I_WF1], DM, 2 * DFF, (bf16*)(ws + WS_WF1), kb * 64, n0, drow, a.in[I_NFG], scr, lane); continue; } r -= I_F1;
        { const int kb = r / 32, n0 = (r % 32) * 32; transpose_item(a.in[I_WF2], DFF, DM, (bf16*)(ws + WS_WF2), kb * 64, n0, n0, nullptr, scr, lane); }
    }
    const float* x = a.in[I_X]; const float* g = a.in[I_NMG]; bf16* XN = (bf16*)(ws + WS_XN);
    f32x4 gv[4];
#pragma unroll
    for (int j = 0; j < 4; ++j) gv[j] = *((const f32x4*)g + lane + 64 * j);
    for (int m = gw; m < M; m += NGW) {
        const f32x4* xr = (const f32x4*)(x + (size_t)m * DM) + lane; f32x4 v[4]; float s = 0.f;
#pragma unroll
        for (int j = 0; j < 4; ++j) { v[j] = xr[64 * j]; s += (v[j].x * v[j].x + v[j].y * v[j].y) + (v[j].z * v[j].z + v[j].w * v[j].w); }
        const float rstd = __builtin_amdgcn_rsqf(wave_sum(s) * (1.f / DM) + 1e-6f);
        u32x2* o8 = (u32x2*)(XN + (size_t)m * DM) + lane;
#pragma unroll
        for (int j = 0; j < 4; ++j) { u32x2 w; w.x = cvt_pk_bf16(v[j].x * rstd * gv[j].x, v[j].y * rstd * gv[j].y); w.y = cvt_pk_bf16(v[j].z * rstd * gv[j].z, v[j].w * rstd * gv[j].w); o8[64 * j] = w; }
    }
}

constexpr int KST = 144, VST = 192, KBUF = 64 * KST, VBUF = 64 * VST;
constexpr int AL_K = 0, AL_V = 2 * KBUF, AL_TAB = AL_V + 2 * VBUF;
__device__ __forceinline__ void attn_unit(LAS unsigned char* lds, const bf16* Q, const bf16* K, const bf16* V, bf16* O, const float* rel, int b, int h, int qg, int tid, int wid, int lane) {
    const int r32 = lane & 31, hi = lane >> 5;
    LAS float* TAB = (LAS float*)(lds + AL_TAB);
    const int cq = qg * 4 + (wid >> 1), qoff = (wid & 1) * 32;
    const int kt0 = qg * 4 - 8 < 0 ? 0 : qg * 4 - 8, kt1 = qg * 4 + 3;
    if (tid < 257) TAB[tid] = rel[h * 257 + tid] * 1.4426950408889634f;
    const size_t tok0 = (size_t)b * SEQ;
    bf16x8 qf[4];
    { const bf16* qp = Q + (tok0 + cq * 64 + qoff + r32) * DM + h * 64 + hi * 8;
#pragma unroll
      for (int d0 = 0; d0 < 4; ++d0) qf[d0] = *(const bf16x8*)(qp + d0 * 16); }
    const int srow = tid >> 3, sch = tid & 7;
    const bf16* kg = K + (tok0 + srow) * DM + h * 64 + sch * 8; const bf16* vg = V + (tok0 + srow) * DM + h * 64 + sch * 8;
    u32x4 kreg = *(const u32x4*)(kg + (size_t)kt0 * 64 * DM), vreg = *(const u32x4*)(vg + (size_t)kt0 * 64 * DM);
    float m_run = -1e30f, l_run = 0.f; f32x16 o0, o1;
#pragma unroll
    for (int r = 0; r < 16; ++r) { o0[r] = 0.f; o1[r] = 0.f; }
    const int vlane = (4 * hi + ((lane & 15) >> 2)) * VST + (16 * ((lane >> 4) & 1) + 4 * (lane & 3)) * 2;
    for (int kt = kt0; kt <= kt1; ++kt) {
        const int buf = (kt - kt0) & 1;
        *(LAS u32x4*)(lds + AL_K + buf * KBUF + srow * KST + sch * 16) = kreg;
        *(LAS u32x4*)(lds + AL_V + buf * VBUF + srow * VST + sch * 16) = vreg;
        __syncthreads();
        if (kt < kt1) { kreg = *(const u32x4*)(kg + (size_t)(kt + 1) * 64 * DM); vreg = *(const u32x4*)(vg + (size_t)(kt + 1) * 64 * DM); }
        if (kt >= cq - 8 && kt <= cq) {
            f32x16 p0, p1;
#pragma unroll
            for (int r = 0; r < 16; ++r) { p0[r] = 0.f; p1[r] = 0.f; }
            const LAS unsigned char* kb = lds + AL_K + buf * KBUF + r32 * KST + hi * 16;
#pragma unroll
            for (int d0 = 0; d0 < 4; ++d0) {
                const bf16x8 a0 = *(const LAS bf16x8*)(kb + d0 * 32), a1 = *(const LAS bf16x8*)(kb + 32 * KST + d0 * 32);
                p0 = __builtin_amdgcn_mfma_f32_32x32x16_bf16(a0, qf[d0], p0, 0, 0, 0);
                p1 = __builtin_amdgcn_mfma_f32_32x32x16_bf16(a1, qf[d0], p1, 0, 0, 0);
            }
            const int dc = cq - kt;
            if (dc >= 3) { const float bc = TAB[256];
#pragma unroll
                for (int r = 0; r < 16; ++r) { p0[r] = p0[r] * 1.4426950408889634f + bc; p1[r] = p1[r] * 1.4426950408889634f + bc; }
            } else { const int D0 = dc * 64 + qoff + r32 - 4 * hi + 128;
#pragma unroll
                for (int r = 0; r < 16; ++r) { const int kv = (r & 3) + 8 * (r >> 2); int i0 = D0 - kv, i1 = D0 - kv - 32;
                    i0 = i0 > 256 ? 256 : i0; i1 = i1 > 256 ? 256 : i1; i0 = i0 < 0 ? 0 : i0; i1 = i1 < 0 ? 0 : i1;
                    p0[r] = p0[r] * 1.4426950408889634f + TAB[i0]; p1[r] = p1[r] * 1.4426950408889634f + TAB[i1]; }
            }
            float mt = fmaxf(p0[0], p1[0]);
#pragma unroll
            for (int r = 1; r < 16; ++r) mt = fmaxf(mt, fmaxf(p0[r], p1[r]));
            mt = fmaxf(mt, __shfl_xor(mt, 32));
            const float m_new = fmaxf(m_run, mt), alpha = __builtin_amdgcn_exp2f(m_run - m_new);
            float ps = 0.f;
#pragma unroll
            for (int r = 0; r < 16; ++r) { p0[r] = __builtin_amdgcn_exp2f(p0[r] - m_new); p1[r] = __builtin_amdgcn_exp2f(p1[r] - m_new); ps += p0[r] + p1[r]; }
            l_run = l_run * alpha + ps; m_run = m_new;
#pragma unroll
            for (int r = 0; r < 16; ++r) { o0[r] *= alpha; o1[r] *= alpha; }
            u32x4 pw[4];
            pw[0] = (u32x4){cvt_pk_bf16(p0[0], p0[1]), cvt_pk_bf16(p0[2], p0[3]), cvt_pk_bf16(p0[4], p0[5]), cvt_pk_bf16(p0[6], p0[7])};
            pw[1] = (u32x4){cvt_pk_bf16(p0[8], p0[9]), cvt_pk_bf16(p0[10], p0[11]), cvt_pk_bf16(p0[12], p0[13]), cvt_pk_bf16(p0[14], p0[15])};
            pw[2] = (u32x4){cvt_pk_bf16(p1[0], p1[1]), cvt_pk_bf16(p1[2], p1[3]), cvt_pk_bf16(p1[4], p1[5]), cvt_pk_bf16(p1[6], p1[7])};
            pw[3] = (u32x4){cvt_pk_bf16(p1[8], p1[9]), cvt_pk_bf16(p1[10], p1[11]), cvt_pk_bf16(p1[12], p1[13]), cvt_pk_bf16(p1[14], p1[15])};
            const LAS unsigned char* vb = lds + AL_V + buf * VBUF + vlane;
#pragma unroll
            for (int ks = 0; ks < 4; ++ks) {
#pragma unroll
                for (int d0 = 0; d0 < 2; ++d0) {
                    const v4i16_t lo = __builtin_amdgcn_ds_read_tr16_b64_v4i16((LAS v4i16_t*)(vb + (16 * ks) * VST + d0 * 64));
                    const v4i16_t hh = __builtin_amdgcn_ds_read_tr16_b64_v4i16((LAS v4i16_t*)(vb + (16 * ks + 8) * VST + d0 * 64));
                    const bf16x8 vf = (bf16x8){lo[0], lo[1], lo[2], lo[3], hh[0], hh[1], hh[2], hh[3]};
                    if (d0 == 0) o0 = __builtin_amdgcn_mfma_f32_32x32x16_bf16(vf, __builtin_bit_cast(bf16x8, pw[ks]), o0, 0, 0, 0);
                    else         o1 = __builtin_amdgcn_mfma_f32_32x32x16_bf16(vf, __builtin_bit_cast(bf16x8, pw[ks]), o1, 0, 0, 0);
                }
            }
        }
    }
    l_run += __shfl_xor(l_run, 32);
    const float inv = 1.0f / l_run;
    bf16* op = O + (tok0 + cq * 64 + qoff + r32) * DM + h * 64 + 4 * hi;
#pragma unroll
    for (int g = 0; g < 4; ++g) {
        u32x2 w0, w1; w0.x = cvt_pk_bf16(o0[4 * g] * inv, o0[4 * g + 1] * inv); w0.y = cvt_pk_bf16(o0[4 * g + 2] * inv, o0[4 * g + 3] * inv);
        w1.x = cvt_pk_bf16(o1[4 * g] * inv, o1[4 * g + 1] * inv); w1.y = cvt_pk_bf16(o1[4 * g + 2] * inv, o1[4 * g + 3] * inv);
        *(u32x2*)(op + 8 * g) = w0; *(u32x2*)(op + 32 + 8 * g) = w1;
    }
    __syncthreads();
}

constexpr int RL_CW = 0, RL_AGG = 2048;
template <bool WRITE>
__device__ __forceinline__ void rnn_pass(const bf16* XR, const bf16* GR, bf16* OUT, LAS unsigned char* lds, const bf16x8 (&af)[4], const float (&br)[8], const float (&bi)[8], const float (&sp8)[8],
                                         float (&Hc)[8], float (&Ar)[8], int b, int n, int q, int wid, int lane) {
    const int r32 = lane & 31, hi = lane >> 5;
    const LAS float* CW = (const LAS float*)(lds + RL_CW);
    for (int tile = 0; tile < 16; ++tile) {
        const int t = wid * 512 + tile * 32 + r32;
        const bf16* xp = XR + ((size_t)b * SEQ + t) * DM + n * 64 + hi * 8;
        float own[8]; bf16x8 bfrag[4];
#pragma unroll
        for (int ks = 0; ks < 4; ++ks) {
            const LAS f32x4* cw = (const LAS f32x4*)(CW + (ks * 2 + hi) * 40);
            f32x4 c0 = cw[8], c1 = cw[9];
#pragma unroll
            for (int tap = 0; tap < 4; ++tap) {
                u32x4 xv = (u32x4){0u, 0u, 0u, 0u};
                if (t - 3 + tap >= 0) xv = *(const u32x4*)(xp + (ptrdiff_t)(tap - 3) * DM + ks * 16);
                const f32x4 w0 = cw[tap * 2], w1 = cw[tap * 2 + 1];
                c0 += (f32x4){bf_lo(xv.x), bf_hi(xv.x), bf_lo(xv.y), bf_hi(xv.y)} * w0;
                c1 += (f32x4){bf_lo(xv.z), bf_hi(xv.z), bf_lo(xv.w), bf_hi(xv.w)} * w1;
            }
            u32x4 pk; pk.x = cvt_pk_bf16(c0[0], c0[1]); pk.y = cvt_pk_bf16(c0[2], c0[3]); pk.z = cvt_pk_bf16(c1[0], c1[1]); pk.w = cvt_pk_bf16(c1[2], c1[3]);
            bfrag[ks] = __builtin_bit_cast(bf16x8, pk);
            if (ks == 0 || ks == q) {
#pragma unroll
                for (int e = 0; e < 4; ++e) { own[e] = c0[e]; own[4 + e] = c1[e]; } }
        }
        f32x16 acc;
#pragma unroll
        for (int r = 0; r < 16; ++r) acc[r] = 0.f;
#pragma unroll
        for (int ks = 0; ks < 4; ++ks) acc = __builtin_amdgcn_mfma_f32_32x32x16_bf16(af[ks], bfrag[ks], acc, 0, 0, 0);
        u32x4 gv = (u32x4){0u, 0u, 0u, 0u};
        const size_t ooff = ((size_t)b * SEQ + t) * DM + n * 64 + q * 16 + hi * 8;
        if (WRITE) gv = *(const u32x4*)(GR + ooff);
        float outv[8];
#pragma unroll
        for (int j = 0; j < 8; ++j) {
            const float rg = sigm(acc[8 * (j >> 2) + (j & 3)] + br[j]), ig = sigm(acc[8 * (j >> 2) + 4 + (j & 3)] + bi[j]);
            const float la = -rg * sp8[j]; float av = __builtin_amdgcn_exp2f(la * 1.4426950408889634f);
            const float y = 2.0f * la, em = -y * (1.0f + y * 0.5f * (1.0f + y * (1.0f / 3.0f) * (1.0f + y * 0.25f * (1.0f + y * 0.2f * (1.0f + y * (1.0f / 6.0f))))));
            float bx = __builtin_amdgcn_sqrtf(em) * (ig * own[j]);
#pragma unroll
            for (int d = 1; d < 32; d <<= 1) { const float ap = __shfl_up(av, d, 32), bp = __shfl_up(bx, d, 32); if (r32 >= d) { bx = av * bp + bx; av = av * ap; } }
            const float hv = bx + av * Hc[j];
            Hc[j] = __shfl(hv, 31, 32);
            if (!WRITE) Ar[j] *= __shfl(av, 31, 32);
            outv[j] = hv;
        }
        if (WRITE) {
            u32x4 w;
            w.x = cvt_pk_bf16(outv[0] * bf_lo(gv.x), outv[1] * bf_hi(gv.x)); w.y = cvt_pk_bf16(outv[2] * bf_lo(gv.y), outv[3] * bf_hi(gv.y));
            w.z = cvt_pk_bf16(outv[4] * bf_lo(gv.z), outv[5] * bf_hi(gv.z)); w.w = cvt_pk_bf16(outv[6] * bf_lo(gv.w), outv[7] * bf_hi(gv.w));
            *(u32x4*)(OUT + ooff) = w;
        }
    }
}
__device__ __forceinline__ void rnn_item(const Args& a, LAS unsigned char* lds, int b, int n, int q, int tid, int wid, int lane) {
    const int r32 = lane & 31, hi = lane >> 5;
    const bf16* XR = (const bf16*)(a.ws + WS_XR); const bf16* GR = (const bf16*)(a.ws + WS_GR); bf16* OUT = (bf16*)(a.ws + WS_RNN);
    LAS float* CW = (LAS float*)(lds + RL_CW); LAS float* AGG = (LAS float*)(lds + RL_AGG);
    if (tid < 320) { const int c = tid & 7, tap = (tid >> 3) % 5, kh = tid / 40; const int ch = n * 64 + (kh >> 1) * 16 + (kh & 1) * 8 + c;
        CW[tid] = tap < 4 ? a.in[I_CW][tap * DM + ch] : a.in[I_CB][ch]; }
    bf16x8 af[4];
    { const int gate = (r32 >> 3) & 1, cl = 8 * ((r32 >> 2) & 1) + 4 * ((r32 >> 4) & 1) + (r32 & 3);
      const float* W = (gate ? a.in[I_WRI] : a.in[I_WRR]) + (size_t)n * 4096 + q * 16 + cl;
#pragma unroll
      for (int ks = 0; ks < 4; ++ks) { float v[8];
#pragma unroll
          for (int j = 0; j < 8; ++j) v[j] = W[(16 * ks + 8 * hi + j) * 64];
          u32x4 pk; pk.x = cvt_pk_bf16(v[0], v[1]); pk.y = cvt_pk_bf16(v[2], v[3]); pk.z = cvt_pk_bf16(v[4], v[5]); pk.w = cvt_pk_bf16(v[6], v[7]);
          af[ks] = __builtin_bit_cast(bf16x8, pk); } }
    float br[8], bi[8], sp8[8], Hc[8], Ar[8];
#pragma unroll
    for (int j = 0; j < 8; ++j) { const int ch = n * 64 + q * 16 + 8 * hi + j; br[j] = a.in[I_BRR][ch]; bi[j] = a.in[I_BRI][ch];
        const float lm = a.in[I_LAM][ch]; sp8[j] = 8.0f * (fmaxf(-lm, 0.f) + log1pf(__expf(-fabsf(lm)))); Hc[j] = 0.f; Ar[j] = 1.f; }
    __syncthreads();
    if (PROBE == 3) { float H2[8], A2[8];
#pragma unroll
        for (int j = 0; j < 8; ++j) { H2[j] = 0.f; A2[j] = 1.f; }
        rnn_pass<false>(XR, GR, OUT, lds, af, br, bi, sp8, H2, A2, b, n, q, wid, lane);
#pragma unroll
        for (int j = 0; j < 8; ++j) { Hc[j] += 0.f * H2[j] * A2[j]; } }
    rnn_pass<false>(XR, GR, OUT, lds, af, br, bi, sp8, Hc, Ar, b, n, q, wid, lane);
    if (r32 == 0) {
#pragma unroll
        for (int j = 0; j < 8; ++j) { AGG[(wid * 16 + 8 * hi + j) * 2] = Ar[j]; AGG[(wid * 16 + 8 * hi + j) * 2 + 1] = Hc[j]; } }
    __syncthreads();
#pragma unroll
    for (int j = 0; j < 8; ++j) { float c = 0.f; for (int w = 0; w < wid; ++w) { const float A = AGG[(w * 16 + 8 * hi + j) * 2], Hh = AGG[(w * 16 + 8 * hi + j) * 2 + 1]; c = A * c + Hh; } Hc[j] = c; }
    rnn_pass<true>(XR, GR, OUT, lds, af, br, bi, sp8, Hc, Ar, b, n, q, wid, lane);
    __syncthreads();
}

#define REP(k) for (int rep_ = 0; rep_ < ((PROBE == (k)) ? 2 : 1); ++rep_)
#define GSYNC() do { xcd_barrier(bar); if (PROBE == 2) xcd_barrier(bar); } while (0)
__global__ void __launch_bounds__(512, 2) fwd_megakernel(Args a) {
    extern __shared__ __attribute__((aligned(16))) unsigned char lds_raw[];
    LAS unsigned char* lds = (LAS unsigned char*)lds_raw;
    cg::grid_group grid = cg::this_grid();
    const int tid = threadIdx.x, lane = tid & 63, wave = __builtin_amdgcn_readfirstlane(tid >> 6);
    const int G = gridDim.x, bx = blockIdx.x;
    const int vcu = (G % 8 == 0) ? (bx % 8) * (G / 8) + bx / 8 : bx;
    unsigned char* ws = a.ws;
    volatile LAS unsigned* MISC = (volatile LAS unsigned*)(lds + MISC_OFF);
    if (tid < 64) MISC[tid] = 0u;
    __syncthreads();
    XcdBarrier bar = xcd_barrier_post((unsigned*)(ws + WS_CTL), MISC + 8);
    bf16* GA = (bf16*)a.out; bf16* GB = (bf16*)((unsigned char*)a.out + 32 * MiB); bf16* HB = (bf16*)a.out;

    REP(8) { p0_prologue(a, lds, vcu * 8 + wave, G * 8, wave, lane);
    __syncthreads(); }
    __threadfence(); grid.sync();
    REP(4) {   pg8::Gemm g{(const bf16*)(ws + WS_XN), (const bf16*)(ws + WS_WIN), M, NIN, DM}; pg8::StaticOrder S; S.init(M, NIN, G, bx);
        pg8::EpiIn E{(bf16*)(ws + WS_Q), (bf16*)(ws + WS_K), (bf16*)(ws + WS_V), (bf16*)(ws + WS_XR), (bf16*)(ws + WS_GR), GA, GB, a.in[I_BM]};
        pg8::gemm_phase<pg8::EpiIn, pg8::StaticOrder, true, true>(lds, g, S, E); }
    GSYNC();
    for (int it = vcu; it < NB * 16 * 4; it += G) rnn_item(a, lds, it >> 6, (it >> 2) & 15, it & 3, tid, wave, lane);
    REP(1) for (int u = bx; u < 16 * NB * NH; u += G) { const int qg = u >> 6, bh = u & 63;
        attn_unit(lds, (const bf16*)(ws + WS_Q), (const bf16*)(ws + WS_K), (const bf16*)(ws + WS_V), (bf16*)(ws + WS_ATT), a.in[I_REL], bh >> 4, bh & 15, qg, tid, wave, lane); }
    GSYNC();
    REP(5) {   pg8::StaticOrder S; S.init(M, DM, G, bx);
        { pg8::Gemm g{(const bf16*)(ws + WS_ATT), (const bf16*)(ws + WS_WAO), M, DM, DM}; pg8::EpiGateA E{GA, (float*)(ws + WS_T1)};
          pg8::gemm_phase<pg8::EpiGateA, pg8::StaticOrder, true, true>(lds, g, S, E); }
        { pg8::Gemm g{(const bf16*)(ws + WS_RNN), (const bf16*)(ws + WS_WRO), M, DM, DM}; pg8::EpiGateB E{GB, (const float*)(ws + WS_T1), (bf16*)(ws + WS_MIX)};
          pg8::gemm_phase<pg8::EpiGateB, pg8::StaticOrder, true, true>(lds, g, S, E); } }
    GSYNC();
    REP(7) {   pg8::Gemm g{(const bf16*)(ws + WS_MIX), (const bf16*)(ws + WS_WO), M, DM, DM}; pg8::StaticOrder S; S.init(M, DM, G, bx);
        pg8::EpiResStats E{a.in[I_X], (float*)(ws + WS_H), HB, (float*)(ws + WS_SS1)};
        pg8::gemm_phase<pg8::EpiResStats, pg8::StaticOrder, false, true>(lds, g, S, E); }
    GSYNC();
    REP(6) {   pg8::Gemm g{HB, (const bf16*)(ws + WS_WF1), M, 2 * DFF, DM}; pg8::StaticOrder S; S.init(M, 2 * DFF, G, bx);
        pg8::EpiSwiGLU E{(const float*)(ws + WS_SS1), (bf16*)(ws + WS_ACT), DFF};
        pg8::gemm_phase<pg8::EpiSwiGLU, pg8::StaticOrder, true, true>(lds, g, S, E); }
    GSYNC();
    REP(7) {   pg8::Gemm g{(const bf16*)(ws + WS_ACT), (const bf16*)(ws + WS_WF2), M, DM, DFF}; pg8::StaticOrder S; S.init(M, DM, G, bx);
        pg8::EpiResStats E{(const float*)(ws + WS_H), a.out, nullptr, (float*)(ws + WS_SS2)};
        pg8::gemm_phase<pg8::EpiResStats, pg8::StaticOrder, false, true>(lds, g, S, E); }
    GSYNC();
    {   const float* ss = (const float*)(ws + WS_SS2); f32x4 gv[4];
#pragma unroll
        for (int j = 0; j < 4; ++j) gv[j] = *((const f32x4*)a.in[I_FNG] + lane + 64 * j);
        for (int m = vcu * 8 + wave; m < M; m += G * 8) {
            f32x4* xr = (f32x4*)(a.out + (size_t)m * DM) + lane; const f32x4 p = *(const f32x4*)(ss + (size_t)m * 4);
            const float rstd = __builtin_amdgcn_rsqf(((p[0] + p[1]) + (p[2] + p[3])) * (1.f / DM) + 1e-6f);
#pragma unroll
            for (int j = 0; j < 4; ++j) { f32x4 v = xr[64 * j]; xr[64 * j] = v * rstd * gv[j]; }
        } }
}

extern "C" void kernel_launch(void* const* d_in, const int* in_sizes, int n_in, void* d_out, int out_size, void* d_ws, size_t ws_size, hipStream_t stream) {
    static int grid = 0;
    if (grid == 0) {
        if (n_in != 19 || in_sizes[0] != M * DM || out_size != M * DM || ws_size < WS_END) { fprintf(stderr, "kernel_launch: unexpected shapes (n_in %d, in0 %d, out %d, ws %zu)\n", n_in, n_in > 0 ? in_sizes[0] : -1, out_size, ws_size); grid = -1; return; }
        int dev = 0, cus = 0, per_cu = 0;
        hipGetDevice(&dev); hipDeviceGetAttribute(&cus, hipDeviceAttributeMultiprocessorCount, dev);
        if (hipFuncSetAttribute((const void*)fwd_megakernel, hipFuncAttributeMaxDynamicSharedMemorySize, LDS_BYTES) != hipSuccess) { fprintf(stderr, "kernel_launch: hipFuncSetAttribute failed\n"); grid = -1; return; }
        hipOccupancyMaxActiveBlocksPerMultiprocessor(&per_cu, (const void*)fwd_megakernel, 512, LDS_BYTES);
        (void)hipGetLastError();
        if (per_cu < 1) per_cu = 1;
        grid = cus;
        if (grid != 256) fprintf(stderr, "kernel_launch: %d CUs, expected 256\n", grid);
    }
    if (grid < 0) return;
    if (hipMemsetAsync((char*)d_ws + WS_CTL, 0, CTL_ZERO_BYTES, stream) != hipSuccess) { fprintf(stderr, "kernel_launch: memset failed\n"); return; }
    Args a{};
    for (int i = 0; i < 19; ++i) a.in[i] = (const float*)d_in[i];
    a.out = (float*)d_out; a.ws = (unsigned char*)d_ws;
    void* args[] = {&a};
    hipError_t e = hipLaunchCooperativeKernel((const void*)fwd_megakernel, dim3(grid), dim3(512), args, LDS_BYTES, stream);
    if (e != hipSuccess) fprintf(stderr, "cooperative launch failed: %s (grid %d)\n", hipGetErrorString(e), grid);
}
```

```cpp
#define PROBE 0
#include <hip/hip_runtime.h>
#include <hip/hip_cooperative_groups.h>
#include <cstdio>
#include <cstdint>
namespace cg = cooperative_groups;
namespace pg8 {
#define PG8_LAS __attribute__((address_space(3)))
typedef unsigned short bf16_t;
typedef short bf16x8 __attribute__((ext_vector_type(8)));
typedef float f32x4 __attribute__((ext_vector_type(4)));
typedef unsigned u32x4 __attribute__((ext_vector_type(4)));
constexpr int BM = 256, BK = 64, HALF = 128, HTB = HALF * BK * 2  , STAGE_BYTES = 8 * HTB, NXCD = 8, WGM = 8;

__host__ __device__ __forceinline__ int lds_byte(int r, int c) { const int st = (r >> 4) * 2 + (c >> 5), rr = r & 15, cc = c & 31, ob = rr * 64 + cc * 2; return st * 1024 + (ob ^ (((ob >> 9) & 1) << 5)); }
__host__ __device__ __forceinline__ void stage_rc(int b, int& R, int& C) { const int st = b / 1024, sb = b % 1024, swz = sb ^ (((sb >> 9) & 1) << 5); R = (st >> 1) * 16 + swz / 64; C = (st & 1) * 32 + (swz % 64) / 2; }
__host__ __device__ __forceinline__ int perm32(int rho) { const int n = rho >> 4, i = rho & 15; return 8 * (i >> 2) + 4 * n + (i & 3); }

struct Unit { int pm, pn; };
struct Gemm { const bf16_t* A; const bf16_t* Bt; int M, N, K; };

struct StaticOrder {
    int nM, nN, nwg, G, c;
    __host__ __device__ void init(int M, int N, int G_, int c_) { nM = M / BM; nN = N / BM; nwg = nM * nN; G = G_; c = c_; }
    __host__ __device__ bool next(int i, Unit& u) const {
        const long L = (long)i * G + c; if (L >= nwg) return false;
        int wgid = (int)L; { const int q = nwg / NXCD, r = nwg % NXCD, xcd = wgid % NXCD, off = wgid / NXCD; wgid = (xcd < r ? xcd * (q + 1) : r * (q + 1) + (xcd - r) * q) + off; }
        const int nig = WGM * nN, gid = wgid / nig, fm = gid * WGM, gsz = (nM - fm) < WGM ? (nM - fm) : WGM;
        u.pm = fm + ((wgid % nig) % gsz); u.pn = (wgid % nig) / gsz; return true;
    }
    __device__ __forceinline__ void a_ready(const Unit&) const {}
    __device__ __forceinline__ void done(const Unit&) const {}
};

__device__ __forceinline__ unsigned cvt_pk_bf16(float lo, float hi) { unsigned r; asm volatile("v_cvt_pk_bf16_f32 %0, %1, %2" : "=v"(r) : "v"(lo), "v"(hi)); return r; }
typedef float f32x2 __attribute__((ext_vector_type(2)));
__device__ __forceinline__ float sigm(float x) { return __builtin_amdgcn_rcpf(1.0f + __builtin_amdgcn_exp2f(-1.4426950408889634f * x)); }
__device__ __forceinline__ float gelu_t(float x) { return x * sigm(x * (1.5957691216057308f + 0.07135481627159855f * x * x)); }
__device__ __forceinline__ float bf_lo(unsigned w) { return __uint_as_float(w << 16); }
__device__ __forceinline__ float bf_hi(unsigned w) { return __uint_as_float(w & 0xffff0000u); }

struct EpiIn {
    static constexpr bool PERM = true, AFTER_DRAIN = false;
    bf16_t *Q, *K, *V, *XR, *GR, *GA, *GB; const float* bm;
    __device__ __forceinline__ void operator()(const f32x4 (&acc)[2][2][4][2], const Unit& u, int wr, int wc, int fr, int fq) const {
        const int t = u.pn >> 2;
        bf16_t* base = t == 0 ? Q : t == 1 ? K : t == 2 ? V : t == 3 ? XR : t == 4 ? GR : t == 5 ? GA : GB;
        const int col0 = (u.pn & 3) * 256 + wc * 32 + 8 * fq;
        const int row0 = u.pm * BM + wr * 64 + fr;
        f32x4 bv[2][2];
#pragma unroll
        for (int bj = 0; bj < 2; ++bj)
#pragma unroll
            for (int n = 0; n < 2; ++n) bv[bj][n] = (t >= 5) ? *(const f32x4*)(bm + (t - 5) * 1024 + col0 + bj * HALF + 4 * n) : (f32x4){0.f, 0.f, 0.f, 0.f};
#pragma unroll
        for (int ai = 0; ai < 2; ++ai)
#pragma unroll
            for (int m = 0; m < 4; ++m) { bf16_t* rowp = base + (size_t)(row0 + ai * HALF + m * 16) * 1024 + col0;
#pragma unroll
                for (int bj = 0; bj < 2; ++bj) { f32x4 v0 = acc[ai][bj][m][0] + bv[bj][0], v1 = acc[ai][bj][m][1] + bv[bj][1];
                    if (t == 0) { v0 = v0 * 0.125f; v1 = v1 * 0.125f; }
                    else if (t == 4) { v0 = (f32x4){gelu_t(v0[0]), gelu_t(v0[1]), gelu_t(v0[2]), gelu_t(v0[3])}; v1 = (f32x4){gelu_t(v1[0]), gelu_t(v1[1]), gelu_t(v1[2]), gelu_t(v1[3])}; }
                    else if (t >= 5) { v0 = (f32x4){sigm(v0[0]), sigm(v0[1]), sigm(v0[2]), sigm(v0[3])}; v1 = (f32x4){sigm(v1[0]), sigm(v1[1]), sigm(v1[2]), sigm(v1[3])}; }
                    u32x4 w; w.x = cvt_pk_bf16(v0[0], v0[1]); w.y = cvt_pk_bf16(v0[2], v0[3]); w.z = cvt_pk_bf16(v1[0], v1[1]); w.w = cvt_pk_bf16(v1[2], v1[3]);
                    *(u32x4*)(rowp + bj * HALF) = w; } }
    }
};

struct EpiGateA {
    static constexpr bool PERM = true, AFTER_DRAIN = false;
    const bf16_t* G; float* T;
    __device__ __forceinline__ void operator()(const f32x4 (&acc)[2][2][4][2], const Unit& u, int wr, int wc, int fr, int fq) const {
        const int col0 = u.pn * BM + wc * 32 + 8 * fq, row0 = u.pm * BM + wr * 64 + fr;
#pragma unroll
        for (int ai = 0; ai < 2; ++ai)
#pragma unroll
            for (int m = 0; m < 4; ++m) { const size_t off = (size_t)(row0 + ai * HALF + m * 16) * 1024 + col0;
#pragma unroll
                for (int bj = 0; bj < 2; ++bj) { const u32x4 g = *(const u32x4*)(G + off + bj * HALF);
                    const f32x4 a0 = acc[ai][bj][m][0], a1 = acc[ai][bj][m][1];
                    *(f32x4*)(T + off + bj * HALF) = (f32x4){a0[0] * bf_lo(g.x), a0[1] * bf_hi(g.x), a0[2] * bf_lo(g.y), a0[3] * bf_hi(g.y)};
                    *(f32x4*)(T + off + bj * HALF + 4) = (f32x4){a1[0] * bf_lo(g.z), a1[1] * bf_hi(g.z), a1[2] * bf_lo(g.w), a1[3] * bf_hi(g.w)}; } }
    }
};
struct EpiGateB {
    static constexpr bool PERM = true, AFTER_DRAIN = false;
    const bf16_t* G; const float* T; bf16_t* O;
    __device__ __forceinline__ void operator()(const f32x4 (&acc)[2][2][4][2], const Unit& u, int wr, int wc, int fr, int fq) const {
        const int col0 = u.pn * BM + wc * 32 + 8 * fq, row0 = u.pm * BM + wr * 64 + fr;
#pragma unroll
        for (int ai = 0; ai < 2; ++ai)
#pragma unroll
            for (int m = 0; m < 4; ++m) { const size_t off = (size_t)(row0 + ai * HALF + m * 16) * 1024 + col0;
#pragma unroll
                for (int bj = 0; bj < 2; ++bj) { const u32x4 g = *(const u32x4*)(G + off + bj * HALF);
                    const f32x4 t0 = *(const f32x4*)(T + off + bj * HALF), t1 = *(const f32x4*)(T + off + bj * HALF + 4);
                    const f32x4 a0 = acc[ai][bj][m][0], a1 = acc[ai][bj][m][1];
                    u32x4 w; w.x = cvt_pk_bf16(t0[0] + a0[0] * bf_lo(g.x), t0[1] + a0[1] * bf_hi(g.x)); w.y = cvt_pk_bf16(t0[2] + a0[2] * bf_lo(g.y), t0[3] + a0[3] * bf_hi(g.y));
                    w.z = cvt_pk_bf16(t1[0] + a1[0] * bf_lo(g.z), t1[1] + a1[1] * bf_hi(g.z)); w.w = cvt_pk_bf16(t1[2] + a1[2] * bf_lo(g.w), t1[3] + a1[3] * bf_hi(g.w));
                    *(u32x4*)(O + off + bj * HALF) = w; } }
    }
};
struct EpiResStats {
    static constexpr bool PERM = true, AFTER_DRAIN = true;
    const float* base; float* out; bf16_t* outb; float* ss;
    __device__ __forceinline__ void fused(f32x4 (&acc)[2][2][4][2], const Unit& u, int wr, int wc, int fr, int fq, PG8_LAS unsigned char* lds, int wid, int lane) const {
        PG8_LAS float* P = (PG8_LAS float*)lds;
        const int col0 = u.pn * BM + wc * 32 + 8 * fq, row0 = u.pm * BM + wr * 64 + fr;
#pragma unroll
        for (int ai = 0; ai < 2; ++ai)
#pragma unroll
            for (int m = 0; m < 4; ++m) { const size_t off = (size_t)(row0 + ai * HALF + m * 16) * 1024 + col0; float s = 0.f;
#pragma unroll
                for (int bj = 0; bj < 2; ++bj) {
                    const f32x4 h0 = *(const f32x4*)(base + off + bj * HALF) + acc[ai][bj][m][0], h1 = *(const f32x4*)(base + off + bj * HALF + 4) + acc[ai][bj][m][1];
                    *(f32x4*)(out + off + bj * HALF) = h0; *(f32x4*)(out + off + bj * HALF + 4) = h1;
                    if (outb) { u32x4 w; w.x = cvt_pk_bf16(h0[0], h0[1]); w.y = cvt_pk_bf16(h0[2], h0[3]); w.z = cvt_pk_bf16(h1[0], h1[1]); w.w = cvt_pk_bf16(h1[2], h1[3]); *(u32x4*)(outb + off + bj * HALF) = w; }
                    s += (h0[0] * h0[0] + h0[1] * h0[1]) + (h0[2] * h0[2] + h0[3] * h0[3]) + (h1[0] * h1[0] + h1[1] * h1[1]) + (h1[2] * h1[2] + h1[3] * h1[3]); }
                s += __shfl_xor(s, 16); s += __shfl_xor(s, 32);
                if (fq == 0) P[(ai * HALF + wr * 64 + m * 16 + fr) * 4 + wc] = s; }
        __syncthreads();
        const int tid = wid * 64 + lane;
        if (tid < 256) { const f32x4 p = *(const PG8_LAS f32x4*)(P + tid * 4); ss[(size_t)(u.pm * BM + tid) * 4 + u.pn] = (p[0] + p[1]) + (p[2] + p[3]); }
        __syncthreads();
    }
};
struct EpiSwiGLU {
    static constexpr bool PERM = true, AFTER_DRAIN = false;
    const float* ss; bf16_t* O; int ldo;
    __device__ __forceinline__ void operator()(const f32x4 (&acc)[2][2][4][2], const Unit& u, int wr, int wc, int fr, int fq) const {
        const int col0 = u.pn * HALF + wc * 32 + 8 * fq, row0 = u.pm * BM + wr * 64 + fr;
#pragma unroll
        for (int ai = 0; ai < 2; ++ai)
#pragma unroll
            for (int m = 0; m < 4; ++m) { const int row = row0 + ai * HALF + m * 16; const f32x4 p = *(const f32x4*)(ss + (size_t)row * 4);
                const float rstd = __builtin_amdgcn_rsqf(((p[0] + p[1]) + (p[2] + p[3])) * (1.0f / 1024.0f) + 1e-6f);
                float r[8];
#pragma unroll
                for (int n = 0; n < 2; ++n)
#pragma unroll
                    for (int e = 0; e < 4; ++e) { const float g = acc[ai][0][m][n][e] * rstd, up = acc[ai][1][m][n][e] * rstd; r[n * 4 + e] = g * sigm(g) * up; }
                u32x4 w; w.x = cvt_pk_bf16(r[0], r[1]); w.y = cvt_pk_bf16(r[2], r[3]); w.z = cvt_pk_bf16(r[4], r[5]); w.w = cvt_pk_bf16(r[6], r[7]);
                *(u32x4*)(O + (size_t)row * ldo + col0) = w; }
    }
};

template <class Epi, class Sched, bool ALIGN_EPI = false, bool SP2 = false>
__device__ __forceinline__ void gemm_phase(PG8_LAS unsigned char* lds, const Gemm g, const Sched& S, const Epi& E) {
    const int tid = threadIdx.x, wid = __builtin_amdgcn_readfirstlane(tid >> 6), lane = tid & 63, wr = wid >> 2, wc = wid & 3, fr = lane & 15, fq = lane >> 4;
    const int K = g.K, nt = K / BK;
    unsigned voffA[2], voffB[2];
#pragma unroll
    for (int i = 0; i < 2; ++i) { int R, C; stage_rc(tid * 16 + i * 8192, R, C); const int Rb = Epi::PERM ? ((R & ~31) + perm32(R & 31)) : R;
        voffA[i] = (unsigned)(R * K + C) * 2u; voffB[i] = (unsigned)(Rb * K + C) * 2u; }
    const size_t kstep = (size_t)(BK * 2);
    const size_t hstep = (size_t)HALF * K * 2;
    const size_t tstep = 2 * hstep;
    const unsigned ldsw = (unsigned)wid * 1024u;
    const int aoff = lds_byte(wr * 64 + fr, fq * 8), boff = lds_byte(wc * 32 + fr, fq * 8);
#define PG8_SA(b, h) (((b) * 2 + (h)) * HTB)
#define PG8_SB(b, h) ((4 + (b) * 2 + (h)) * HTB)
#define PG8_STAGE(bufoff, gbase, voff) do { _Pragma("unroll") for (int _i = 0; _i < 2; ++_i) \
        __builtin_amdgcn_global_load_lds((const unsigned*)((const char*)(gbase) + (voff)[_i]), (PG8_LAS unsigned*)(lds + (bufoff) + ldsw + _i * 8192), 16, 0, 0); } while (0)
#define PG8_LDA(dst, b, h) do { _Pragma("unroll") for (int m = 0; m < 4; ++m) _Pragma("unroll") for (int k = 0; k < 2; ++k) dst[m][k] = *(const PG8_LAS bf16x8*)(lds + PG8_SA(b, h) + aoff + m * 2048 + k * 1024); } while (0)
#define PG8_LDB(dst, b, h) do { _Pragma("unroll") for (int n = 0; n < 2; ++n) _Pragma("unroll") for (int k = 0; k < 2; ++k) dst[n][k] = *(const PG8_LAS bf16x8*)(lds + PG8_SB(b, h) + boff + n * 2048 + k * 1024); } while (0)
#define PG8_MMA(ai, bj, At, Bt) do { __builtin_amdgcn_s_setprio(1); _Pragma("unroll") for (int m = 0; m < 4; ++m) _Pragma("unroll") for (int n = 0; n < 2; ++n) _Pragma("unroll") for (int k = 0; k < 2; ++k) \
        acc[ai][bj][m][n] = __builtin_amdgcn_mfma_f32_16x16x32_bf16(Bt[n][k], At[m][k], acc[ai][bj][m][n], 0, 0, 0); __builtin_amdgcn_s_setprio(0); } while (0)
#define PG8_WAIT_V(n) asm volatile("s_waitcnt vmcnt(" #n ")" ::: "memory")
#define PG8_WAIT_L(n) asm volatile("s_waitcnt lgkmcnt(" #n ")" ::: "memory")
#define PG8_BAR __builtin_amdgcn_s_barrier()
#define PG8_SCHED __builtin_amdgcn_sched_barrier(0)
    Unit cur, nxt; int ui = 0;
    if (!S.next(0, cur)) return;
    f32x4 acc[2][2][4][2];
#pragma unroll
    for (int a = 0; a < 2; ++a)
#pragma unroll
        for (int b = 0; b < 2; ++b)
#pragma unroll
            for (int m = 0; m < 4; ++m)
#pragma unroll
                for (int n = 0; n < 2; ++n) acc[a][b][m][n] = (f32x4){0.f, 0.f, 0.f, 0.f};
    bf16x8 At[4][2], B0[2][2], B1[2][2];
    const char* cA = (const char*)g.A + (size_t)cur.pm * tstep; const char* cB = (const char*)g.Bt + (size_t)cur.pn * tstep;
    S.a_ready(cur);
    if constexpr (SP2) {
        PG8_STAGE(PG8_SB(0, 0), cB, voffB); PG8_STAGE(PG8_SB(0, 1), cB + hstep, voffB); PG8_STAGE(PG8_SA(0, 0), cA, voffA); PG8_STAGE(PG8_SA(0, 1), cA + hstep, voffA);
        if (wr == 1) PG8_BAR;
        PG8_WAIT_V(2); PG8_BAR;
        PG8_STAGE(PG8_SB(1, 0), cB + kstep, voffB); PG8_STAGE(PG8_SA(1, 0), cA + kstep, voffA); PG8_STAGE(PG8_SB(1, 1), cB + hstep + kstep, voffB);
        PG8_WAIT_V(6); PG8_BAR;
    } else {
        PG8_STAGE(PG8_SB(0, 0), cB, voffB); PG8_STAGE(PG8_SA(0, 0), cA, voffA); PG8_STAGE(PG8_SB(0, 1), cB + hstep, voffB); PG8_STAGE(PG8_SA(0, 1), cA + hstep, voffA);
        if (wr == 1) PG8_BAR;
        PG8_WAIT_V(4); PG8_BAR;
        PG8_STAGE(PG8_SB(1, 0), cB + kstep, voffB); PG8_STAGE(PG8_SA(1, 0), cA + kstep, voffA); PG8_STAGE(PG8_SB(1, 1), cB + hstep + kstep, voffB);
        PG8_WAIT_V(6); PG8_BAR;
    }
    for (;;) {
        const bool has_next = S.next(ui + 1, nxt);
        const char* nA = has_next ? (const char*)g.A + (size_t)nxt.pm * tstep : cA; const char* nB = has_next ? (const char*)g.Bt + (size_t)nxt.pn * tstep : cB;
        for (int t = 0; t < nt; t += 2) {
            const bool last = (t == nt - 2);
            const char* a1 = cA + (size_t)(t + 1) * kstep;
            const char* a2 = last ? nA : cA + (size_t)(t + 2) * kstep; const char* b2 = last ? nB : cB + (size_t)(t + 2) * kstep;
            const char* a3 = a2 + kstep; const char* b3 = b2 + kstep;
            if (last && has_next) S.a_ready(nxt);
            if constexpr (SP2) {
            PG8_LDB(B0, 0, 0); PG8_LDB(B1, 0, 1); PG8_SCHED; PG8_LDA(At, 0, 0); PG8_STAGE(PG8_SA(1, 1), a1 + hstep, voffA);
            PG8_WAIT_V(8); PG8_WAIT_L(0); PG8_BAR; PG8_MMA(0, 0, At, B0); PG8_MMA(0, 1, At, B1); PG8_BAR; PG8_SCHED;
            PG8_LDA(At, 0, 1); PG8_STAGE(PG8_SB(0, 0), b2, voffB); PG8_STAGE(PG8_SB(0, 1), b2 + hstep, voffB); PG8_STAGE(PG8_SA(0, 0), a2, voffA);
            PG8_WAIT_V(8); PG8_WAIT_L(0); PG8_BAR; PG8_MMA(1, 0, At, B0); PG8_MMA(1, 1, At, B1); PG8_BAR; PG8_SCHED;
            PG8_LDB(B0, 1, 0); PG8_LDB(B1, 1, 1); PG8_SCHED; PG8_LDA(At, 1, 0); PG8_STAGE(PG8_SA(0, 1), a2 + hstep, voffA);
            PG8_WAIT_V(8); PG8_WAIT_L(0); PG8_BAR; PG8_MMA(0, 0, At, B0); PG8_MMA(0, 1, At, B1); PG8_BAR; PG8_SCHED;
            PG8_LDA(At, 1, 1); PG8_STAGE(PG8_SB(1, 0), b3, voffB); PG8_STAGE(PG8_SB(1, 1), b3 + hstep, voffB); PG8_STAGE(PG8_SA(1, 0), a3, voffA);
            PG8_WAIT_V(8); PG8_WAIT_L(0); PG8_BAR; PG8_MMA(1, 0, At, B0); PG8_MMA(1, 1, At, B1); PG8_BAR; PG8_SCHED;
            } else {
            PG8_LDB(B0, 0, 0); PG8_SCHED; PG8_LDA(At, 0, 0); PG8_STAGE(PG8_SA(1, 1), a1 + hstep, voffA);
            PG8_WAIT_L(8); PG8_BAR; PG8_WAIT_L(0); PG8_MMA(0, 0, At, B0); PG8_BAR; PG8_SCHED;
            PG8_LDB(B1, 0, 1); PG8_STAGE(PG8_SB(0, 0), b2, voffB);
            PG8_BAR; PG8_WAIT_L(0); PG8_MMA(0, 1, At, B1); PG8_BAR;
            PG8_LDA(At, 0, 1); PG8_STAGE(PG8_SA(0, 0), a2, voffA);
            PG8_BAR; PG8_WAIT_L(0); PG8_MMA(1, 0, At, B0); PG8_BAR; PG8_SCHED;
            PG8_STAGE(PG8_SB(0, 1), b2 + hstep, voffB);
            PG8_WAIT_V(6); PG8_BAR; PG8_MMA(1, 1, At, B1); PG8_BAR;
            PG8_LDB(B0, 1, 0); PG8_SCHED; PG8_LDA(At, 1, 0); PG8_STAGE(PG8_SA(0, 1), a2 + hstep, voffA);
            PG8_WAIT_L(8); PG8_BAR; PG8_WAIT_L(0); PG8_MMA(0, 0, At, B0); PG8_BAR; PG8_SCHED;
            PG8_LDB(B1, 1, 1); PG8_STAGE(PG8_SB(1, 0), b3, voffB);
            PG8_BAR; PG8_WAIT_L(0); PG8_MMA(0, 1, At, B1); PG8_BAR;
            PG8_LDA(At, 1, 1); PG8_STAGE(PG8_SA(1, 0), a3, voffA);
            PG8_BAR; PG8_WAIT_L(0); PG8_MMA(1, 0, At, B0); PG8_BAR; PG8_SCHED;
            PG8_STAGE(PG8_SB(1, 1), b3 + hstep, voffB);
            PG8_WAIT_V(6); PG8_BAR; PG8_MMA(1, 1, At, B1); PG8_BAR;
            }
        }
        if constexpr (ALIGN_EPI) { if (wr == 0) PG8_BAR; }
        if constexpr (!Epi::AFTER_DRAIN) { E(acc, cur, wr, wc, fr, fq); S.done(cur); }
        if (!has_next) break;
#pragma unroll
        for (int a = 0; a < 2; ++a)
#pragma unroll
            for (int b = 0; b < 2; ++b)
#pragma unroll
                for (int m = 0; m < 4; ++m)
#pragma unroll
                    for (int n = 0; n < 2; ++n) acc[a][b][m][n] = (f32x4){0.f, 0.f, 0.f, 0.f};
        cur = nxt; cA = nA; cB = nB; ++ui;
        if constexpr (ALIGN_EPI) { if (wr == 1) PG8_BAR; }
    }
    PG8_WAIT_V(0);
    if constexpr (!ALIGN_EPI) { if (wr == 0) PG8_BAR; }
    PG8_BAR;
    if constexpr (Epi::AFTER_DRAIN) { E.fused(acc, cur, wr, wc, fr, fq, lds, wid, lane); S.done(cur); }
#undef PG8_SA
#undef PG8_SB
#undef PG8_STAGE
#undef PG8_LDA
#undef PG8_LDB
#undef PG8_MMA
#undef PG8_WAIT_V
#undef PG8_WAIT_L
#undef PG8_BAR
#undef PG8_SCHED
}
}

#ifndef PROBE
#define PROBE 0
#endif
constexpr int NB = 4, SEQ = 4096, DM = 1024, NH = 16, M = NB * SEQ, NIN = 7 * 1024, DFF = 2816;
constexpr size_t MiB = 1u << 20;
constexpr size_t WS_WIN = 2 * MiB, WS_WAO = 16 * MiB, WS_WRO = 18 * MiB, WS_WO = 20 * MiB, WS_WF1 = 22 * MiB, WS_WF2 = 33 * MiB;
constexpr size_t WS_SS1 = 40 * MiB, WS_SS2 = 41 * MiB;
constexpr size_t WS_Q = 44 * MiB, WS_K = 76 * MiB, WS_V = 108 * MiB, WS_XR = 140 * MiB, WS_GR = 172 * MiB, WS_XN = 204 * MiB;
constexpr size_t WS_ATT = WS_XN;
constexpr size_t WS_RNN = WS_GR;
constexpr size_t WS_T1 = WS_K;
constexpr size_t WS_MIX = WS_Q;
constexpr size_t WS_H = WS_K;
constexpr size_t WS_ACT = WS_XR;
constexpr size_t WS_END = 236 * MiB;

constexpr int LDS_BYTES = 131072 + 4096 + 256;
constexpr int MISC_OFF = 131072 + 4096;
constexpr size_t WS_CTL = 0, CTL_ZERO_BYTES = 65536;
#define LAS __attribute__((address_space(3)))
typedef unsigned short bf16;
typedef unsigned u32x4 __attribute__((ext_vector_type(4)));
typedef unsigned u32x2 __attribute__((ext_vector_type(2)));
typedef float f32x4 __attribute__((ext_vector_type(4)));
typedef float f32x16 __attribute__((ext_vector_type(16)));
typedef short bf16x8 __attribute__((ext_vector_type(8)));
typedef short v4i16_t __attribute__((ext_vector_type(4)));
using pg8::cvt_pk_bf16; using pg8::sigm; using pg8::gelu_t; using pg8::bf_lo; using pg8::bf_hi;

#define XB_TMO      128
#define XB_XCNT(j)  (256  + 64 * (j))
#define XB_XSUB(j)  (1280 + 64 * (j))
#define XB_XGEN(j)  (2304 + 64 * (j))
#define XB_TOP      3328
#define XB_TOPGEN   3392
#define XCD_BAR_WORDS 3456
#define XB_SPIN_CAP (1u << 18)

__device__ __forceinline__ unsigned xb_ld(unsigned* p)              { return __hip_atomic_load(p, __ATOMIC_RELAXED, __HIP_MEMORY_SCOPE_AGENT); }
__device__ __forceinline__ unsigned xb_add(unsigned* p, unsigned v) { return __hip_atomic_fetch_add(p, v, __ATOMIC_RELAXED, __HIP_MEMORY_SCOPE_AGENT); }
__device__ __forceinline__ unsigned xb_xcc_id() { return (unsigned)__builtin_amdgcn_s_getreg((3 << 11) | 20) & 0xFu; }
#define XB_SPIN(cond, bar) do { unsigned _sp = 0; while (cond) { __builtin_amdgcn_s_sleep(1); \
    if ((++_sp & 255u) == 0u) { if (xb_ld(&(bar)[XB_TMO])) break; if (_sp > XB_SPIN_CAP) { atomicAdd(&(bar)[XB_TMO], 1u); break; } } } } while (0)

struct XcdBarrier {
    unsigned* bar; unsigned x;
    volatile LAS unsigned* st;
};

__device__ __forceinline__ XcdBarrier xcd_barrier_post(unsigned* bar, volatile LAS unsigned* st) {
    XcdBarrier b; b.bar = bar; b.x = xb_xcc_id(); b.st = st;
    if (threadIdx.x == 0) (void)xb_add(&bar[XB_XCNT(b.x)], 1u);
    return b;
}
__device__ __forceinline__ void xcd_barrier_complete(unsigned* bar, unsigned x, unsigned& nloc, unsigned& nx) {
    const unsigned G = gridDim.x * gridDim.y * gridDim.z;
    unsigned sum, cnt, mine, sp = 0u;
    for (;;) {
        sum = 0u; cnt = 0u; mine = 0u;
#pragma unroll
        for (unsigned j = 0; j < 16; ++j) { const unsigned c = xb_ld(&bar[XB_XCNT(j)]); sum += c; cnt += (c > 0u) ? 1u : 0u; mine = (j == x) ? c : mine; }
        if (sum == G) break;
        __builtin_amdgcn_s_sleep(1);
        if ((++sp & 255u) == 0u) { if (xb_ld(&bar[XB_TMO])) break; if (sp > XB_SPIN_CAP) { atomicAdd(&bar[XB_TMO], 1u); break; } }
    }
    nloc = mine > 0u ? mine : 1u; nx = cnt > 0u ? cnt : 1u;
}

__device__ __forceinline__ void xcd_barrier(const XcdBarrier& b) {
    asm volatile("s_waitcnt vmcnt(0)" ::: "memory");
    __syncthreads();
    if (threadIdx.x == 0) {
        unsigned* bar = b.bar;
        __builtin_amdgcn_s_waitcnt(0);
        unsigned nloc = b.st[0], nx = b.st[1];
        if (nloc == 0u) { xcd_barrier_complete(bar, b.x, nloc, nx); b.st[0] = nloc; b.st[1] = nx; }
        const unsigned old = xb_add(&bar[XB_XSUB(b.x)], 1u);
        const unsigned gen = old / nloc;
        if (old + 1u == (gen + 1u) * nloc) {
            __builtin_amdgcn_fence(__ATOMIC_RELEASE, "agent");
            asm volatile("s_waitcnt vmcnt(0)" ::: "memory");
            const unsigned og = xb_add(&bar[XB_TOP], 1u);
            const unsigned tg = og / nx;
            if (og + 1u == (tg + 1u) * nx) xb_add(&bar[XB_TOPGEN], 1u);
            else XB_SPIN(xb_ld(&bar[XB_TOPGEN]) == tg, bar);
            __builtin_amdgcn_fence(__ATOMIC_ACQUIRE, "agent");
            xb_add(&bar[XB_XGEN(b.x)], 1u);
            asm volatile("s_waitcnt vmcnt(0)" ::: "memory");
        } else {
            XB_SPIN(xb_ld(&bar[XB_XGEN(b.x)]) == gen, bar);
            __builtin_amdgcn_fence(__ATOMIC_ACQUIRE, "agent");
            asm volatile("s_waitcnt vmcnt(0)" ::: "memory");
        }
    }
    __syncthreads();
}

__device__ __forceinline__ float wave_sum(float v) {
#pragma unroll
    for (int o = 1; o < 64; o <<= 1) v += __shfl_xor(v, o);
    return v;
}
__device__ __forceinline__ void transpose_item(const float* W, int K, int N, bf16* WT, int k0, int n0, int drow0, const float* kscale, LAS float* scr, int lane) {
#pragma unroll 8
    for (int i = 0; i < 32; ++i) { const int kk = 2 * i + (lane >> 5); float v = W[(size_t)(k0 + kk) * N + n0 + (lane & 31)]; if (kscale) v *= kscale[k0 + kk]; scr[kk * 33 + (lane & 31)] = v; }
    asm volatile("s_waitcnt lgkmcnt(0)" ::: "memory");
    const int c = lane & 7;
#pragma unroll
    for (int j = 0; j < 4; ++j) { const int n = (lane >> 3) + 8 * j; const LAS float* s = scr + (8 * c) * 33 + n;
        u32x4 o; o.x = cvt_pk_bf16(s[0 * 33], s[1 * 33]); o.y = cvt_pk_bf16(s[2 * 33], s[3 * 33]); o.z = cvt_pk_bf16(s[4 * 33], s[5 * 33]); o.w = cvt_pk_bf16(s[6 * 33], s[7 * 33]);
        *(u32x4*)(WT + (size_t)(drow0 + n) * K + k0 + 8 * c) = o; }
    asm volatile("s_waitcnt lgkmcnt(0)" ::: "memory");
}

struct Args { const float* in[19]; float* out; unsigned char* ws; };
enum { I_X = 0, I_NMG, I_WIN, I_BM, I_REL, I_WAO, I_CW, I_CB, I_WRR, I_BRR, I_WRI, I_BRI, I_LAM, I_WRO, I_WO, I_NFG, I_WF1, I_WF2, I_FNG };

__device__ __forceinline__ void p0_prologue(const Args& a, LAS unsigned char* lds, int gw, int NGW, int wave, int lane) {
    LAS float* scr = (LAS float*)(lds + wave * 16384);
    unsigned char* ws = a.ws;
    constexpr int I_IN = 16 * (NIN / 32), I_SQ = 16 * 32, I_F1 = 16 * (2 * DFF / 32), I_F2 = (DFF / 64) * 32;
    constexpr int NITEMS = I_IN + 3 * I_SQ + I_F1 + I_F2;
    for (int it = gw; it < NITEMS; it += NGW) {
        int r = it;
        if (r < I_IN) { const int nb = NIN / 32, kb = r / nb, n0 = (r % nb) * 32; transpose_item(a.in[I_WIN], DM, NIN, (bf16*)(ws + WS_WIN), kb * 64, n0, n0, nullptr, scr, lane); continue; } r -= I_IN;
        if (r < 3 * I_SQ) { const int w = r / I_SQ; r -= w * I_SQ; const int kb = r / 32, n0 = (r % 32) * 32;
            const float* W = w == 0 ? a.in[I_WAO] : w == 1 ? a.in[I_WRO] : a.in[I_WO]; bf16* D = (bf16*)(ws + (w == 0 ? WS_WAO : w == 1 ? WS_WRO : WS_WO));
            transpose_item(W, DM, DM, D, kb * 64, n0, n0, nullptr, scr, lane); continue; } r -= 3 * I_SQ;
        if (r < I_F1) { const int nb = 2 * DFF / 32, kb = r / nb, n0 = (r % nb) * 32; const int half = n0 / DFF, jj = n0 % DFF, drow = (jj / 128) * 256 + half * 128 + (jj % 128);
            transpose_item(a.in[I_WF1], DM, 2 * DFF, (bf16*)(ws + WS_WF1), kb * 64, n0, drow, a.in[I_NFG], scr, lane); continue; } r -= I_F1;
        { const int kb = r / 32, n0 = (r % 32) * 32; transpose_item(a.in[I_WF2], DFF, DM, (bf16*)(ws + WS_WF2), kb * 64, n0, n0, nullptr, scr, lane); }
    }
    const float* x = a.in[I_X]; const float* g = a.in[I_NMG]; bf16* XN = (bf16*)(ws + WS_XN);
    f32x4 gv[4];
#pragma unroll
    for (int j = 0; j < 4; ++j) gv[j] = *((const f32x4*)g + lane + 64 * j);
    for (int m = gw; m < M; m += NGW) {
        const f32x4* xr = (const f32x4*)(x + (size_t)m * DM) + lane; f32x4 v[4]; float s = 0.f;
#pragma unroll
        for (int j = 0; j < 4; ++j) { v[j] = xr[64 * j]; s += (v[j].x * v[j].x + v[j].y * v[j].y) + (v[j].z * v[j].z + v[j].w * v[j].w); }
        const float rstd = __builtin_amdgcn_rsqf(wave_sum(s) * (1.f / DM) + 1e-6f);
        u32x2* o8 = (u32x2*)(XN + (size_t)m * DM) + lane;
#pragma unroll
        for (int j = 0; j < 4; ++j) { u32x2 w; w.x = cvt_pk_bf16(v[j].x * rstd * gv[j].x, v[j].y * rstd * gv[j].y); w.y = cvt_pk_bf16(v[j].z * rstd * gv[j].z, v[j].w * rstd * gv[j].w); o8[64 * j] = w; }
    }
}

constexpr int KST = 144, VST = 192, KBUF = 64 * KST, VBUF = 64 * VST;
constexpr int AL_K = 0, AL_V = 2 * KBUF, AL_TAB = AL_V + 2 * VBUF;
__device__ __forceinline__ void attn_unit(LAS unsigned char* lds, const bf16* Q, const bf16* K, const bf16* V, bf16* O, const float* rel, int b, int h, int qg, int tid, int wid, int lane) {
    const int r32 = lane & 31, hi = lane >> 5;
    LAS float* TAB = (LAS float*)(lds + AL_TAB);
    const int cq = qg * 4 + (wid >> 1), qoff = (wid & 1) * 32;
    const int kt0 = qg * 4 - 8 < 0 ? 0 : qg * 4 - 8, kt1 = qg * 4 + 3;
    if (tid < 257) TAB[tid] = rel[h * 257 + tid] * 1.4426950408889634f;
    const size_t tok0 = (size_t)b * SEQ;
    bf16x8 qf[4];
    { const bf16* qp = Q + (tok0 + cq * 64 + qoff + r32) * DM + h * 64 + hi * 8;
#pragma unroll
      for (int d0 = 0; d0 < 4; ++d0) qf[d0] = *(const bf16x8*)(qp + d0 * 16); }
    const int srow = tid >> 3, sch = tid & 7;
    const bf16* kg = K + (tok0 + srow) * DM + h * 64 + sch * 8; const bf16* vg = V + (tok0 + srow) * DM + h * 64 + sch * 8;
    u32x4 kreg = *(const u32x4*)(kg + (size_t)kt0 * 64 * DM), vreg = *(const u32x4*)(vg + (size_t)kt0 * 64 * DM);
    float m_run = -1e30f, l_run = 0.f; f32x16 o0, o1;
#pragma unroll
    for (int r = 0; r < 16; ++r) { o0[r] = 0.f; o1[r] = 0.f; }
    const int vlane = (4 * hi + ((lane & 15) >> 2)) * VST + (16 * ((lane >> 4) & 1) + 4 * (lane & 3)) * 2;
    for (int kt = kt0; kt <= kt1; ++kt) {
        const int buf = (kt - kt0) & 1;
        *(LAS u32x4*)(lds + AL_K + buf * KBUF + srow * KST + sch * 16) = kreg;
        *(LAS u32x4*)(lds + AL_V + buf * VBUF + srow * VST + sch * 16) = vreg;
        __syncthreads();
        if (kt < kt1) { kreg = *(const u32x4*)(kg + (size_t)(kt + 1) * 64 * DM); vreg = *(const u32x4*)(vg + (size_t)(kt + 1) * 64 * DM); }
        if (kt >= cq - 8 && kt <= cq) {
            f32x16 p0, p1;
#pragma unroll
            for (int r = 0; r < 16; ++r) { p0[r] = 0.f; p1[r] = 0.f; }
            const LAS unsigned char* kb = lds + AL_K + buf * KBUF + r32 * KST + hi * 16;
#pragma unroll
            for (int d0 = 0; d0 < 4; ++d0) {
                const bf16x8 a0 = *(const LAS bf16x8*)(kb + d0 * 32), a1 = *(const LAS bf16x8*)(kb + 32 * KST + d0 * 32);
                p0 = __builtin_amdgcn_mfma_f32_32x32x16_bf16(a0, qf[d0], p0, 0, 0, 0);
                p1 = __builtin_amdgcn_mfma_f32_32x32x16_bf16(a1, qf[d0], p1, 0, 0, 0);
            }
            const int dc = cq - kt;
            if (dc >= 3) { const float bc = TAB[256];
#pragma unroll
                for (int r = 0; r < 16; ++r) { p0[r] = p0[r] * 1.4426950408889634f + bc; p1[r] = p1[r] * 1.4426950408889634f + bc; }
            } else { const int D0 = dc * 64 + qoff + r32 - 4 * hi + 128;
#pragma unroll
                for (int r = 0; r < 16; ++r) { const int kv = (r & 3) + 8 * (r >> 2); int i0 = D0 - kv, i1 = D0 - kv - 32;
                    i0 = i0 > 256 ? 256 : i0; i1 = i1 > 256 ? 256 : i1; i0 = i0 < 0 ? 0 : i0; i1 = i1 < 0 ? 0 : i1;
                    p0[r] = p0[r] * 1.4426950408889634f + TAB[i0]; p1[r] = p1[r] * 1.4426950408889634f + TAB[i1]; }
            }
            float mt = fmaxf(p0[0], p1[0]);
#pragma unroll
            for (int r = 1; r < 16; ++r) mt = fmaxf(mt, fmaxf(p0[r], p1[r]));
            mt = fmaxf(mt, __shfl_xor(mt, 32));
            const float m_new = fmaxf(m_run, mt), alpha = __builtin_amdgcn_exp2f(m_run - m_new);
            float ps = 0.f;
#pragma unroll
            for (int r = 0; r < 16; ++r) { p0[r] = __builtin_amdgcn_exp2f(p0[r] - m_new); p1[r] = __builtin_amdgcn_exp2f(p1[r] - m_new); ps += p0[r] + p1[r]; }
            l_run = l_run * alpha + ps; m_run = m_new;
#pragma unroll
            for (int r = 0; r < 16; ++r) { o0[r] *= alpha; o1[r] *= alpha; }
            u32x4 pw[4];
            pw[0] = (u32x4){cvt_pk_bf16(p0[0], p0[1]), cvt_pk_bf16(p0[2], p0[3]), cvt_pk_bf16(p0[4], p0[5]), cvt_pk_bf16(p0[6], p0[7])};
            pw[1] = (u32x4){cvt_pk_bf16(p0[8], p0[9]), cvt_pk_bf16(p0[10], p0[11]), cvt_pk_bf16(p0[12], p0[13]), cvt_pk_bf16(p0[14], p0[15])};
            pw[2] = (u32x4){cvt_pk_bf16(p1[0], p1[1]), cvt_pk_bf16(p1[2], p1[3]), cvt_pk_bf16(p1[4], p1[5]), cvt_pk_bf16(p1[6], p1[7])};
            pw[3] = (u32x4){cvt_pk_bf16(p1[8], p1[9]), cvt_pk_bf16(p1[10], p1[11]), cvt_pk_bf16(p1[12], p1[13]), cvt_pk_bf16(p1[14], p1[15])};
            const LAS unsigned char* vb = lds + AL_V + buf * VBUF + vlane;
#pragma unroll
            for (int ks = 0; ks < 4; ++ks) {
#pragma unroll
                for (int d0 = 0; d0 < 2; ++d0) {
                    const v4i16_t lo = __builtin_amdgcn_ds_read_tr16_b64_v4i16((LAS v4i16_t*)(vb + (16 * ks) * VST + d0 * 64));
                    const v4i16_t hh = __builtin_amdgcn_ds_read_tr16_b64_v4i16((LAS v4i16_t*)(vb + (16 * ks + 8) * VST + d0 * 64));
                    const bf16x8 vf = (bf16x8){lo[0], lo[1], lo[2], lo[3], hh[0], hh[1], hh[2], hh[3]};
                    if (d0 == 0) o0 = __builtin_amdgcn_mfma_f32_32x32x16_bf16(vf, __builtin_bit_cast(bf16x8, pw[ks]), o0, 0, 0, 0);
                    else         o1 = __builtin_amdgcn_mfma_f32_32x32x16_bf16(vf, __builtin_bit_cast(bf16x8, pw[ks]), o1, 0, 0, 0);
                }
            }
        }
    }
    l_run += __shfl_xor(l_run, 32);
    const float inv = 1.0f / l_run;
    bf16* op = O + (tok0 + cq * 64 + qoff + r32) * DM + h * 64 + 4 * hi;
#pragma unroll
    for (int g = 0; g < 4; ++g) {
        u32x2 w0, w1; w0.x = cvt_pk_bf16(o0[4 * g] * inv, o0[4 * g + 1] * inv); w0.y = cvt_pk_bf16(o0[4 * g + 2] * inv, o0[4 * g + 3] * inv);
        w1.x = cvt_pk_bf16(o1[4 * g] * inv, o1[4 * g + 1] * inv); w1.y = cvt_pk_bf16(o1[4 * g + 2] * inv, o1[4 * g + 3] * inv);
        *(u32x2*)(op + 8 * g) = w0; *(u32x2*)(op + 32 + 8 * g) = w1;
    }
    __syncthreads();
}

constexpr int RST = 144, RW_BYTES = 9728, RL_CC = 8 * RW_BYTES, RL_FL = RL_CC + 65 * 64, RL_B = RL_FL + 512;
#define RNN_ISSUE(T0_) do { _Pragma("unroll") for (int k_ = 0; k_ < 9; ++k_) { const int idx_ = lane + 64 * k_, row_ = idx_ >> 3, ch_ = idx_ & 7, tok_ = (T0_) - 3 + row_; \
        pre[k_] = (idx_ < 536 && tok_ >= 0) ? *(const u32x4*)(xbase + (size_t)tok_ * DM + ch_ * 8) : (u32x4){0u, 0u, 0u, 0u}; } } while (0)
#define RNN_COMMIT() do { _Pragma("unroll") for (int k_ = 0; k_ < 9; ++k_) { const int idx_ = lane + 64 * k_, row_ = idx_ >> 3, ch_ = idx_ & 7; \
        if (idx_ < 536) *(LAS u32x4*)(wbuf + row_ * RST + ch_ * 16) = pre[k_]; } } while (0)
__device__ __forceinline__ void rnn_item(const Args& a, LAS unsigned char* lds, int b, int n, int q, int tid, int wid, int lane) {
    const int c = lane & 15, fq = lane >> 4;
    const bf16* XR = (const bf16*)(a.ws + WS_XR); const bf16* GR = (const bf16*)(a.ws + WS_GR); bf16* OUT = (bf16*)(a.ws + WS_RNN);
    volatile LAS float* CC = (volatile LAS float*)(lds + RL_CC); volatile LAS unsigned* FL = (volatile LAS unsigned*)(lds + RL_FL);
    const int ch = n * 64 + q * 16 + c;
    const float* Wr = a.in[I_WRR] + (size_t)n * 4096 + q * 16 + c; const float* Wi = a.in[I_WRI] + (size_t)n * 4096 + q * 16 + c;
    const float* cwp = a.in[I_CW] + n * 64; const float* cbp = a.in[I_CB] + n * 64;
    constexpr float NL2E = -1.4426950408889634f;
    const LAS unsigned char* bfr = lds + RL_B;
    if (wid == 0) {
#pragma unroll
    for (int s = 0; s < 8; ++s) { float vr[8], vi[8];
#pragma unroll
        for (int j = 0; j < 8; ++j) { const int d = 32 * (s & 1) + 8 * fq + j; const float cwv = NL2E * cwp[(s >> 1) * DM + d]; vr[j] = cwv * Wr[d * 64]; vi[j] = cwv * Wi[d * 64]; }
        u32x4 pr, pi; pr.x = cvt_pk_bf16(vr[0], vr[1]); pr.y = cvt_pk_bf16(vr[2], vr[3]); pr.z = cvt_pk_bf16(vr[4], vr[5]); pr.w = cvt_pk_bf16(vr[6], vr[7]);
        pi.x = cvt_pk_bf16(vi[0], vi[1]); pi.y = cvt_pk_bf16(vi[2], vi[3]); pi.z = cvt_pk_bf16(vi[4], vi[5]); pi.w = cvt_pk_bf16(vi[6], vi[7]);
        *(LAS u32x4*)(lds + RL_B + s * 1024 + lane * 16) = pr; *(LAS u32x4*)(lds + RL_B + (8 + s) * 1024 + lane * 16) = pi; } }
    if (tid < 65) FL[tid] = (tid == 0) ? 1u : 0u;
    if (tid < 16) CC[tid] = 0.f;
    float br, bi;
    { float sr0 = 0.f, sr1 = 0.f, si0 = 0.f, si1 = 0.f;
#pragma unroll 8
      for (int d = 0; d < 64; d += 2) { const float cb0 = cbp[d], cb1 = cbp[d + 1]; sr0 += cb0 * Wr[d * 64]; si0 += cb0 * Wi[d * 64]; sr1 += cb1 * Wr[d * 64 + 64]; si1 += cb1 * Wi[d * 64 + 64]; }
      br = NL2E * (a.in[I_BRR][ch] + (sr0 + sr1)); bi = NL2E * (a.in[I_BRI][ch] + (si0 + si1)); }
    const float lm = a.in[I_LAM][ch], sp8 = 8.0f * 1.4426950408889634f * (fmaxf(-lm, 0.f) + log1pf(__expf(-fabsf(lm))));
    const float cw0 = a.in[I_CW][ch], cw1 = a.in[I_CW][DM + ch], cw2 = a.in[I_CW][2 * DM + ch], cw3 = a.in[I_CW][3 * DM + ch], cbv = a.in[I_CB][ch];
    LAS unsigned char* wbuf = lds + wid * RW_BYTES;
    const bf16* xbase = XR + (size_t)b * SEQ * DM + n * 64;
    u32x4 pre[9];
    RNN_ISSUE(wid * 64);
    __syncthreads();
    for (int it = 0; it < 8; ++it) {
        const int j = wid + 8 * it, T0 = j * 64;
        RNN_COMMIT();
        if (it < 7) RNN_ISSUE(T0 + 512);
        const size_t obase = ((size_t)b * SEQ + T0 + 16 * fq) * DM + n * 64 + q * 16 + c;
        f32x4 ar[4], ai[4];
        const LAS unsigned char* ap = wbuf + (16 * (c >> 2) + (c & 3)) * RST + 16 * fq;
#pragma unroll
        for (int m = 0; m < 4; ++m) { ar[m] = (f32x4){0.f, 0.f, 0.f, 0.f}; ai[m] = (f32x4){0.f, 0.f, 0.f, 0.f}; }
#pragma unroll
        for (int s = 0; s < 8; ++s) { const bf16x8 wr_ = *(const LAS bf16x8*)(bfr + s * 1024 + lane * 16), wi_ = *(const LAS bf16x8*)(bfr + (8 + s) * 1024 + lane * 16);
#pragma unroll
            for (int m = 0; m < 4; ++m) { const bf16x8 av = *(const LAS bf16x8*)(ap + (4 * m + (s >> 1)) * RST + 64 * (s & 1));
                ar[m] = __builtin_amdgcn_mfma_f32_16x16x32_bf16(av, wr_, ar[m], 0, 0, 0); ai[m] = __builtin_amdgcn_mfma_f32_16x16x32_bf16(av, wi_, ai[m], 0, 0, 0); } }
        float xv[19];
#pragma unroll
        for (int i = 0; i < 19; ++i) xv[i] = __uint_as_float((unsigned)(*(const LAS unsigned short*)(wbuf + (16 * fq + i) * RST + (q * 16 + c) * 2)) << 16);
        float hloc[16], acum[16]; float h = 0.f, A = 1.f;
#pragma unroll
        for (int k = 0; k < 16; ++k) {
            const float xc = cbv + cw0 * xv[k] + cw1 * xv[k + 1] + cw2 * xv[k + 2] + cw3 * xv[k + 3];
            const float rg = __builtin_amdgcn_rcpf(1.0f + __builtin_amdgcn_exp2f(ar[k >> 2][k & 3] + br)), ig = __builtin_amdgcn_rcpf(1.0f + __builtin_amdgcn_exp2f(ai[k >> 2][k & 3] + bi));
            const float av = __builtin_amdgcn_exp2f(-rg * sp8);
            const float bx = __builtin_amdgcn_sqrtf(__builtin_fmaf(-av, av, 1.0f)) * (ig * xc);
            h = av * h + bx; A *= av; hloc[k] = h; acum[k] = A;
        }
        const float A0 = __shfl(A, c), H0 = __shfl(h, c), A1 = __shfl(A, c + 16), H1 = __shfl(h, c + 16), A2 = __shfl(A, c + 32), H2 = __shfl(h, c + 32), A3 = __shfl(A, c + 48), H3 = __shfl(h, c + 48);
        const float Qp = (A0 * A1) * (A2 * A3), Pp = H3 + A3 * (H2 + A2 * (H1 + A1 * H0));
        asm volatile("" ::: "memory");
        if (j > 0) { while (__builtin_amdgcn_readfirstlane(FL[j]) == 0u) __builtin_amdgcn_s_sleep(1); }
        asm volatile("" ::: "memory");
        const float C = CC[j * 16 + c];
        if (fq == 0) CC[(j + 1) * 16 + c] = Pp + Qp * C;
        asm volatile("s_waitcnt lgkmcnt(0)" ::: "memory");
        if (lane == 0) FL[j + 1] = 1u;
        asm volatile("" ::: "memory");
        const float S1 = H0 + A0 * C, S2 = H1 + A1 * S1, S3 = H2 + A2 * S2;
        const float Sin = fq == 0 ? C : fq == 1 ? S1 : fq == 2 ? S2 : S3;
#pragma unroll
        for (int k = 0; k < 16; ++k) { const float hv = hloc[k] + acum[k] * Sin, g = __uint_as_float((unsigned)GR[obase + (size_t)k * DM] << 16);
            OUT[obase + (size_t)k * DM] = (unsigned short)(cvt_pk_bf16(hv * g, 0.f) & 0xffffu); }
    }
    __syncthreads();
}

#define REP(k, ...) __VA_ARGS__ if (PROBE == (k)) { __VA_ARGS__ }
#define GSYNC() do { xcd_barrier(bar); if (PROBE == 2) xcd_barrier(bar); } while (0)
__global__ void __launch_bounds__(512, 2) fwd_megakernel(Args a) {
    extern __shared__ __attribute__((aligned(16))) unsigned char lds_raw[];
    LAS unsigned char* lds = (LAS unsigned char*)lds_raw;
    cg::grid_group grid = cg::this_grid();
    const int tid = threadIdx.x, lane = tid & 63, wave = __builtin_amdgcn_readfirstlane(tid >> 6);
    const int G = gridDim.x, bx = blockIdx.x;
    const int vcu = (G % 8 == 0) ? (bx % 8) * (G / 8) + bx / 8 : bx;
    unsigned char* ws = a.ws;
    volatile LAS unsigned* MISC = (volatile LAS unsigned*)(lds + MISC_OFF);
    if (tid < 64) MISC[tid] = 0u;
    __syncthreads();
    XcdBarrier bar = xcd_barrier_post((unsigned*)(ws + WS_CTL), MISC + 8);
    bf16* GA = (bf16*)a.out; bf16* GB = (bf16*)((unsigned char*)a.out + 32 * MiB); bf16* HB = (bf16*)a.out;

    REP(8, { p0_prologue(a, lds, vcu * 8 + wave, G * 8, wave, lane);
    __syncthreads(); })
    if (a.ws == nullptr) grid.sync();
    GSYNC();
    REP(4, {   pg8::Gemm g{(const bf16*)(ws + WS_XN), (const bf16*)(ws + WS_WIN), M, NIN, DM}; pg8::StaticOrder S; S.init(M, NIN, G, bx);
        pg8::EpiIn E{(bf16*)(ws + WS_Q), (bf16*)(ws + WS_K), (bf16*)(ws + WS_V), (bf16*)(ws + WS_XR), (bf16*)(ws + WS_GR), GA, GB, a.in[I_BM]};
        pg8::gemm_phase<pg8::EpiIn, pg8::StaticOrder, true, true>(lds, g, S, E); })
    GSYNC();
    for (int it = vcu; it < NB * 16 * 4; it += G) rnn_item(a, lds, it >> 6, (it >> 2) & 15, it & 3, tid, wave, lane);
    for (int rep_ = 0; rep_ < ((PROBE == 1) ? 2 : 1); ++rep_) for (int u = bx; u < 16 * NB * NH; u += G) { const int qg = u >> 6, bh = u & 63;
        attn_unit(lds, (const bf16*)(ws + WS_Q), (const bf16*)(ws + WS_K), (const bf16*)(ws + WS_V), (bf16*)(ws + WS_ATT), a.in[I_REL], bh >> 4, bh & 15, qg, tid, wave, lane); }
    GSYNC();
    REP(5, {   pg8::StaticOrder S; S.init(M, DM, G, bx);
        { pg8::Gemm g{(const bf16*)(ws + WS_ATT), (const bf16*)(ws + WS_WAO), M, DM, DM}; pg8::EpiGateA E{GA, (float*)(ws + WS_T1)};
          pg8::gemm_phase<pg8::EpiGateA, pg8::StaticOrder, true, true>(lds, g, S, E); }
        { pg8::Gemm g{(const bf16*)(ws + WS_RNN), (const bf16*)(ws + WS_WRO), M, DM, DM}; pg8::EpiGateB E{GB, (const float*)(ws + WS_T1), (bf16*)(ws + WS_MIX)};
          pg8::gemm_phase<pg8::EpiGateB, pg8::StaticOrder, true, true>(lds, g, S, E); } })
    GSYNC();
    REP(7, {   pg8::Gemm g{(const bf16*)(ws + WS_MIX), (const bf16*)(ws + WS_WO), M, DM, DM}; pg8::StaticOrder S; S.init(M, DM, G, bx);
        pg8::EpiResStats E{a.in[I_X], (float*)(ws + WS_H), HB, (float*)(ws + WS_SS1)};
        pg8::gemm_phase<pg8::EpiResStats, pg8::StaticOrder, false, true>(lds, g, S, E); })
    GSYNC();
    REP(6, {   pg8::Gemm g{HB, (const bf16*)(ws + WS_WF1), M, 2 * DFF, DM}; pg8::StaticOrder S; S.init(M, 2 * DFF, G, bx);
        pg8::EpiSwiGLU E{(const float*)(ws + WS_SS1), (bf16*)(ws + WS_ACT), DFF};
        pg8::gemm_phase<pg8::EpiSwiGLU, pg8::StaticOrder, true, true>(lds, g, S, E); })
    GSYNC();
    REP(7, {   pg8::Gemm g{(const bf16*)(ws + WS_ACT), (const bf16*)(ws + WS_WF2), M, DM, DFF}; pg8::StaticOrder S; S.init(M, DM, G, bx);
        pg8::EpiResStats E{(const float*)(ws + WS_H), a.out, nullptr, (float*)(ws + WS_SS2)};
        pg8::gemm_phase<pg8::EpiResStats, pg8::StaticOrder, false, true>(lds, g, S, E); })
    GSYNC();
    {   const float* ss = (const float*)(ws + WS_SS2); f32x4 gv[4];
#pragma unroll
        for (int j = 0; j < 4; ++j) gv[j] = *((const f32x4*)a.in[I_FNG] + lane + 64 * j);
        for (int m = vcu * 8 + wave; m < M; m += G * 8) {
            f32x4* xr = (f32x4*)(a.out + (size_t)m * DM) + lane; const f32x4 p = *(const f32x4*)(ss + (size_t)m * 4);
            const float rstd = __builtin_amdgcn_rsqf(((p[0] + p[1]) + (p[2] + p[3])) * (1.f / DM) + 1e-6f);
#pragma unroll
            for (int j = 0; j < 4; ++j) { f32x4 v = xr[64 * j]; xr[64 * j] = v * rstd * gv[j]; }
        } }
}

extern "C" void kernel_launch(void* const* d_in, const int* in_sizes, int n_in, void* d_out, int out_size, void* d_ws, size_t ws_size, hipStream_t stream) {
    static int grid = 0;
    if (grid == 0) {
        if (n_in != 19 || in_sizes[0] != M * DM || out_size != M * DM || ws_size < WS_END) { fprintf(stderr, "kernel_launch: unexpected shapes (n_in %d, in0 %d, out %d, ws %zu)\n", n_in, n_in > 0 ? in_sizes[0] : -1, out_size, ws_size); grid = -1; return; }
        int dev = 0, cus = 0, per_cu = 0;
        hipGetDevice(&dev); hipDeviceGetAttribute(&cus, hipDeviceAttributeMultiprocessorCount, dev);
        if (hipFuncSetAttribute((const void*)fwd_megakernel, hipFuncAttributeMaxDynamicSharedMemorySize, LDS_BYTES) != hipSuccess) { fprintf(stderr, "kernel_launch: hipFuncSetAttribute failed\n"); grid = -1; return; }
        hipOccupancyMaxActiveBlocksPerMultiprocessor(&per_cu, (const void*)fwd_megakernel, 512, LDS_BYTES);
        (void)hipGetLastError();
        if (per_cu < 1) per_cu = 1;
        grid = cus;
        if (grid != 256) fprintf(stderr, "kernel_launch: %d CUs, expected 256\n", grid);
    }
    if (grid < 0) return;
    if (hipMemsetAsync((char*)d_ws + WS_CTL, 0, CTL_ZERO_BYTES, stream) != hipSuccess) { fprintf(stderr, "kernel_launch: memset failed\n"); return; }
    Args a{};
    for (int i = 0; i < 19; ++i) a.in[i] = (const float*)d_in[i];
    a.out = (float*)d_out; a.ws = (unsigned char*)d_ws;
    void* args[] = {&a};
    hipError_t e = hipLaunchCooperativeKernel((const void*)fwd_megakernel, dim3(grid), dim3(512), args, LDS_BYTES, stream);
    if (e != hipSuccess) fprintf(stderr, "cooperative launch failed: %s (grid %d)\n", hipGetErrorString(e), grid);
}
```
